# Optimizing an MI355X kernel written in HIP

```python
import math
import jax, jax.numpy as jnp
from jax import lax
import numpy as np

D_MODEL = 1024
BATCH = 4
SEQ = 4096
DEPTH = 4

BRANCH_WIDTH = D_MODEL // 2
N_BRANCH = 3
S5_WIDTH = BRANCH_WIDTH
S5_GROUP = 16
S5_GROUPS = S5_WIDTH // S5_GROUP
S5_STATE = 64
S5_DT_MIN = 0.001
S5_DT_MAX = 0.1
LRU_WIDTH = BRANCH_WIDTH
LRU_HEADS = 8
LRU_HEAD_DIM = LRU_WIDTH // LRU_HEADS
LRU_C = 8.0
LRU_A_MIN = 0.9
LRU_A_MAX = 0.999
CONV_WIDTH = 4
FOX_HEAD_DIM = 64
FOX_HEADS = BRANCH_WIDTH // FOX_HEAD_DIM
FOX_WIDTH = FOX_HEADS * FOX_HEAD_DIM
FOX_FORGET_BIAS = 3.0
Q_BLOCK = 128
FFN_HIDDEN = ((8 * D_MODEL + 3 * 256 - 1) // (3 * 256)) * 256
ALPHA = (2.0 * DEPTH) ** 0.25
BETA = (8.0 * DEPTH) ** -0.25
LN_EPS = 1e-5
IN_SIZES = (S5_WIDTH, LRU_WIDTH, LRU_WIDTH, FOX_WIDTH, FOX_WIDTH, FOX_WIDTH, FOX_HEADS, N_BRANCH * D_MODEL)
IN_TOTAL = sum(IN_SIZES)

kernel_name = "hybrid_s5_rglru_fox_deepnorm"


def _layer_norm(x, g, b):
    x32 = x.astype(jnp.float32)
    mu = jnp.mean(x32, axis=-1, keepdims=True)
    var = jnp.mean(jnp.square(x32 - mu), axis=-1, keepdims=True)
    y = (x32 - mu) * lax.rsqrt(var + LN_EPS) * g.astype(jnp.float32) + b.astype(jnp.float32)
    return y.astype(x.dtype)


def _linear_scan(a, b):
    def combine(left, right):
        a_l, b_l = left
        a_r, b_r = right
        return a_r * a_l, a_r * b_l + b_r
    _, h = lax.associative_scan(combine, (a, b), axis=1)
    return h


def _s5_branch(u, a_re, a_im, log_dt, b_re, b_im, c_re, c_im, d_skip, w_glu, b_glu):
    bsz, L, _ = u.shape
    f32 = jnp.float32
    ug = u.astype(f32).reshape(bsz, L, S5_GROUPS, S5_GROUP)
    lam = lax.complex(a_re.astype(f32), a_im.astype(f32))
    dt = jnp.exp(log_dt.astype(f32))[:, None]
    lam_bar = jnp.exp(lam * dt)
    b_c = lax.complex(b_re.astype(f32), b_im.astype(f32))
    b_bar = ((lam_bar - 1.0) / lam)[:, :, None] * b_c
    bu = jnp.einsum('blgc,gpc->blgp', ug.astype(jnp.complex64), b_bar)
    h = _linear_scan(jnp.broadcast_to(lam_bar, bu.shape), bu)
    c_c = lax.complex(c_re.astype(f32), c_im.astype(f32))
    y = jnp.einsum('blgp,gcp->blgc', h, c_c).real + d_skip.astype(f32).reshape(S5_GROUPS, S5_GROUP) * ug
    y = jax.nn.gelu(y.reshape(bsz, L, S5_WIDTH))
    y = y * jax.nn.sigmoid(y @ w_glu.astype(f32) + b_glu.astype(f32))
    return y.astype(u.dtype)


def _rglru_branch(xb, gate, conv_w, conv_b, w_a, b_a, w_x, b_x, lam):
    bsz, L, _ = xb.shape
    f32 = jnp.float32
    xp = jnp.pad(xb, ((0, 0), (CONV_WIDTH - 1, 0), (0, 0)))
    xc = conv_b + sum(conv_w[k] * xp[:, k:k + L] for k in range(CONV_WIDTH))
    xh = xc.reshape(bsz, L, LRU_HEADS, LRU_HEAD_DIM)
    r = jax.nn.sigmoid(jnp.einsum('blhi,hij->blhj', xh, w_a) + b_a).astype(f32)
    i = jax.nn.sigmoid(jnp.einsum('blhi,hij->blhj', xh, w_x) + b_x).astype(f32)
    log_a = -LRU_C * jax.nn.softplus(-lam.astype(f32).reshape(LRU_HEADS, LRU_HEAD_DIM)) * r
    a = jnp.exp(log_a)
    mult = jnp.sqrt(-jnp.expm1(2.0 * log_a))
    h = _linear_scan(a, mult * (i * xh.astype(f32)))
    y = jax.nn.gelu(gate.astype(f32)) * h.reshape(bsz, L, LRU_WIDTH)
    return y.astype(xb.dtype)


def _fox_branch(q, k, v, fg_logit, b_f):
    bsz, L, _ = q.shape
    f32 = jnp.float32
    q = q.reshape(bsz, L, FOX_HEADS, FOX_HEAD_DIM)
    k = k.reshape(bsz, L, FOX_HEADS, FOX_HEAD_DIM)
    v = v.reshape(bsz, L, FOX_HEADS, FOX_HEAD_DIM)
    log_f = jax.nn.log_sigmoid((fg_logit + b_f).astype(f32))
    cum = jnp.cumsum(log_f, axis=1).transpose(0, 2, 1)
    kpos = jnp.arange(L)
    scale = FOX_HEAD_DIM ** -0.5

    def one_block(blk):
        start = blk * Q_BLOCK
        qb = lax.dynamic_slice_in_dim(q, start, Q_BLOCK, axis=1)
        cq = lax.dynamic_slice_in_dim(cum, start, Q_BLOCK, axis=2)
        s = jnp.einsum('bqhd,bkhd->bhqk', qb, k).astype(f32) * scale
        s = s + cq[..., None] - cum[:, :, None, :]
        qpos = start + jnp.arange(Q_BLOCK)
        s = jnp.where(kpos[None, :] <= qpos[:, None], s, -jnp.inf)
        p = jax.nn.softmax(s, axis=-1)
        return jnp.einsum('bhqk,bkhd->bqhd', p.astype(v.dtype), v)

    out = lax.map(one_block, jnp.arange(L // Q_BLOCK))
    return out.transpose(1, 0, 2, 3, 4).reshape(bsz, L, FOX_WIDTH)


def setup_inputs(seed: int = 0) -> dict:
    key = jax.random.key(seed)
    ks = iter(jax.random.split(key, 40))
    f32 = jnp.float32

    def nrm(shape, scale):
        return scale * jax.random.normal(next(ks), shape, f32)

    n = jnp.arange(S5_STATE, dtype=f32)
    x = nrm((BATCH, SEQ, D_MODEL), 1.0)
    w_in = nrm((DEPTH, D_MODEL, IN_TOTAL), D_MODEL ** -0.5)
    b_f = FOX_FORGET_BIAS + nrm((DEPTH, FOX_HEADS), 0.1)
    b_gate = nrm((DEPTH, N_BRANCH * D_MODEL), 0.01)
    s5_a_re = -0.5 + nrm((DEPTH, S5_GROUPS, S5_STATE), 0.01)
    s5_a_im = math.pi * n + nrm((DEPTH, S5_GROUPS, S5_STATE), 0.01)
    s5_log_dt = jax.random.uniform(next(ks), (DEPTH, S5_GROUPS), f32, math.log(S5_DT_MIN), math.log(S5_DT_MAX))
    s5_b_re = nrm((DEPTH, S5_GROUPS, S5_STATE, S5_GROUP), (2 * S5_GROUP) ** -0.5)
    s5_b_im = nrm((DEPTH, S5_GROUPS, S5_STATE, S5_GROUP), (2 * S5_GROUP) ** -0.5)
    s5_c_re = nrm((DEPTH, S5_GROUPS, S5_GROUP, S5_STATE), (2 * S5_STATE) ** -0.5)
    s5_c_im = nrm((DEPTH, S5_GROUPS, S5_GROUP, S5_STATE), (2 * S5_STATE) ** -0.5)
    s5_d = nrm((DEPTH, S5_WIDTH), 1.0)
    s5_w_glu = nrm((DEPTH, S5_WIDTH, S5_WIDTH), S5_WIDTH ** -0.5)
    s5_b_glu = nrm((DEPTH, S5_WIDTH), 0.01)
    lru_conv_w = nrm((DEPTH, CONV_WIDTH, LRU_WIDTH), CONV_WIDTH ** -0.5)
    lru_conv_b = nrm((DEPTH, LRU_WIDTH), 0.01)
    lru_w_a = nrm((DEPTH, LRU_HEADS, LRU_HEAD_DIM, LRU_HEAD_DIM), LRU_HEAD_DIM ** -0.5)
    lru_b_a = nrm((DEPTH, LRU_HEADS, LRU_HEAD_DIM), 0.01)
    lru_w_x = nrm((DEPTH, LRU_HEADS, LRU_HEAD_DIM, LRU_HEAD_DIM), LRU_HEAD_DIM ** -0.5)
    lru_b_x = nrm((DEPTH, LRU_HEADS, LRU_HEAD_DIM), 0.01)
    a_c = jax.random.uniform(next(ks), (DEPTH, LRU_WIDTH), f32, LRU_A_MIN, LRU_A_MAX)
    sig = a_c ** (1.0 / LRU_C)
    lru_lambda = jnp.log(sig) - jnp.log1p(-sig)
    w_branch = nrm((DEPTH, N_BRANCH, BRANCH_WIDTH, D_MODEL), BRANCH_WIDTH ** -0.5)
    w_out = nrm((DEPTH, D_MODEL, D_MODEL), BETA * D_MODEL ** -0.5)
    ln1_g = 1.0 + nrm((DEPTH, D_MODEL), 0.01)
    ln1_b = nrm((DEPTH, D_MODEL), 0.01)
    w_ffn_gate = nrm((DEPTH, D_MODEL, FFN_HIDDEN), D_MODEL ** -0.5)
    w_ffn_up = nrm((DEPTH, D_MODEL, FFN_HIDDEN), D_MODEL ** -0.5)
    w_ffn_down = nrm((DEPTH, FFN_HIDDEN, D_MODEL), BETA * FFN_HIDDEN ** -0.5)
    ln2_g = 1.0 + nrm((DEPTH, D_MODEL), 0.01)
    ln2_b = nrm((DEPTH, D_MODEL), 0.01)
    return {"x": x, "w_in": w_in, "b_f": b_f, "b_gate": b_gate,
            "s5_a_re": s5_a_re, "s5_a_im": s5_a_im, "s5_log_dt": s5_log_dt,
            "s5_b_re": s5_b_re, "s5_b_im": s5_b_im, "s5_c_re": s5_c_re, "s5_c_im": s5_c_im,
            "s5_d": s5_d, "s5_w_glu": s5_w_glu, "s5_b_glu": s5_b_glu,
            "lru_conv_w": lru_conv_w, "lru_conv_b": lru_conv_b,
            "lru_w_a": lru_w_a, "lru_b_a": lru_b_a, "lru_w_x": lru_w_x, "lru_b_x": lru_b_x,
            "lru_lambda": lru_lambda, "w_branch": w_branch, "w_out": w_out,
            "ln1_g": ln1_g, "ln1_b": ln1_b,
            "w_ffn_gate": w_ffn_gate, "w_ffn_up": w_ffn_up, "w_ffn_down": w_ffn_down,
            "ln2_g": ln2_g, "ln2_b": ln2_b}


def reference(x, w_in, b_f, b_gate, s5_a_re, s5_a_im, s5_log_dt, s5_b_re, s5_b_im, s5_c_re, s5_c_im,
              s5_d, s5_w_glu, s5_b_glu, lru_conv_w, lru_conv_b, lru_w_a, lru_b_a, lru_w_x, lru_b_x,
              lru_lambda, w_branch, w_out, ln1_g, ln1_b, w_ffn_gate, w_ffn_up, w_ffn_down, ln2_g, ln2_b):
    split_at = np.cumsum(IN_SIZES)[:-1].tolist()
    bsz, L, _ = x.shape
    for l in range(DEPTH):
        z = x @ w_in[l]
        u_s5, x_lru, g_lru, q, k, v, fg, gate_logits = jnp.split(z, split_at, axis=-1)
        y_s5 = _s5_branch(u_s5, s5_a_re[l], s5_a_im[l], s5_log_dt[l], s5_b_re[l], s5_b_im[l],
                          s5_c_re[l], s5_c_im[l], s5_d[l], s5_w_glu[l], s5_b_glu[l])
        y_lru = _rglru_branch(x_lru, g_lru, lru_conv_w[l], lru_conv_b[l], lru_w_a[l], lru_b_a[l],
                              lru_w_x[l], lru_b_x[l], lru_lambda[l])
        y_fox = _fox_branch(q, k, v, fg, b_f[l])
        ys = jnp.stack([y_s5, y_lru, y_fox], axis=2)
        proj = jnp.einsum('blkc,kcd->blkd', ys, w_branch[l])
        gates = jax.nn.sigmoid(gate_logits + b_gate[l]).reshape(bsz, L, N_BRANCH, D_MODEL)
        mixed = jnp.sum(gates * proj, axis=2) @ w_out[l]
        x = _layer_norm(ALPHA * x + mixed, ln1_g[l], ln1_b[l])
        hid = jax.nn.silu(x @ w_ffn_gate[l]) * (x @ w_ffn_up[l])
        x = _layer_norm(ALPHA * x + hid @ w_ffn_down[l], ln2_g[l], ln2_b[l])
    return x
```

```cpp
#include <hip/hip_runtime.h>
#include <hip/hip_cooperative_groups.h>
#include <cstdio>
#include <cstdint>
namespace cg = cooperative_groups;
namespace pg8 {
#define PG8_LAS __attribute__((address_space(3)))
typedef unsigned short bf16_t;
typedef short bf16x8 __attribute__((ext_vector_type(8)));
typedef float f32x4 __attribute__((ext_vector_type(4)));
typedef unsigned u32x4 __attribute__((ext_vector_type(4)));
constexpr int BM = 256, BK = 64, HALF = 128, HTB = HALF * BK * 2  , STAGE_BYTES = 8 * HTB, NXCD = 8, WGM = 8;

__host__ __device__ __forceinline__ int lds_byte(int r, int c) { const int st = (r >> 4) * 2 + (c >> 5), rr = r & 15, cc = c & 31, ob = rr * 64 + cc * 2; return st * 1024 + (ob ^ (((ob >> 9) & 1) << 5)); }
__host__ __device__ __forceinline__ void stage_rc(int b, int& R, int& C) { const int st = b / 1024, sb = b % 1024, swz = sb ^ (((sb >> 9) & 1) << 5); R = (st >> 1) * 16 + swz / 64; C = (st & 1) * 32 + (swz % 64) / 2; }
__host__ __device__ __forceinline__ int perm32(int rho) { const int n = rho >> 4, i = rho & 15; return 8 * (i >> 2) + 4 * n + (i & 3); }

struct Unit { int pm, pn; };
struct Gemm { const bf16_t* A; const bf16_t* Bt; int M, N, K; };

struct StaticOrder {
    int nM, nN, nwg, G, c;
    __host__ __device__ void init(int M, int N, int G_, int c_) { nM = M / BM; nN = N / BM; nwg = nM * nN; G = G_; c = c_; }
    __host__ __device__ bool next(int i, Unit& u) const {
        const long L = (long)i * G + c; if (L >= nwg) return false;
        int wgid = (int)L; { const int q = nwg / NXCD, r = nwg % NXCD, xcd = wgid % NXCD, off = wgid / NXCD; wgid = (xcd < r ? xcd * (q + 1) : r * (q + 1) + (xcd - r) * q) + off; }
        const int nig = WGM * nN, gid = wgid / nig, fm = gid * WGM, gsz = (nM - fm) < WGM ? (nM - fm) : WGM;
        u.pm = fm + ((wgid % nig) % gsz); u.pn = (wgid % nig) / gsz; return true;
    }
    __device__ __forceinline__ void a_ready(const Unit&) const {}
    __device__ __forceinline__ void done(const Unit&) const {}
};

__device__ __forceinline__ unsigned cvt_pk_bf16(float lo, float hi) { unsigned r; asm volatile("v_cvt_pk_bf16_f32 %0, %1, %2" : "=v"(r) : "v"(lo), "v"(hi)); return r; }
template <class Epi, class Sched, bool ALIGN_EPI = false, bool SP2 = false>
__device__ __forceinline__ void gemm_phase(PG8_LAS unsigned char* lds, const Gemm g, const Sched& S, const Epi& E) {
    int tid_raw_ = threadIdx.x; asm volatile("" : "+v"(tid_raw_));
    const int tid = tid_raw_, wid = __builtin_amdgcn_readfirstlane(tid >> 6), lane = tid & 63, wr = wid >> 2, wc = wid & 3, fr = lane & 15, fq = lane >> 4;
    const int K = g.K, nt = K / BK;
    unsigned voffA[2], voffB[2];
#pragma unroll
    for (int i = 0; i < 2; ++i) { int R, C; stage_rc(tid * 16 + i * 8192, R, C); const int Rb = Epi::PERM ? ((R & ~31) + perm32(R & 31)) : R;
        voffA[i] = (unsigned)(R * K + C) * 2u; voffB[i] = (unsigned)(Rb * K + C) * 2u; }
    const size_t kstep = (size_t)(BK * 2);
    const size_t hstep = (size_t)HALF * K * 2;
    const size_t tstep = 2 * hstep;
    const unsigned ldsw = (unsigned)wid * 1024u;
    const int aoff = lds_byte(wr * 64 + fr, fq * 8), boff = lds_byte(wc * 32 + fr, fq * 8);
#define PG8_SA(b, h) (((b) * 2 + (h)) * HTB)
#define PG8_SB(b, h) ((4 + (b) * 2 + (h)) * HTB)
#define PG8_STAGE(bufoff, gbase, voff) do { _Pragma("unroll") for (int _i = 0; _i < 2; ++_i) \
        __builtin_amdgcn_global_load_lds((const unsigned*)((const char*)(gbase) + (voff)[_i]), (PG8_LAS unsigned*)(lds + (bufoff) + ldsw + _i * 8192), 16, 0, 0); } while (0)
#define PG8_LDA(dst, b, h) do { _Pragma("unroll") for (int m = 0; m < 4; ++m) _Pragma("unroll") for (int k = 0; k < 2; ++k) dst[m][k] = *(const PG8_LAS bf16x8*)(lds + PG8_SA(b, h) + aoff + m * 2048 + k * 1024); } while (0)
#define PG8_LDB(dst, b, h) do { _Pragma("unroll") for (int n = 0; n < 2; ++n) _Pragma("unroll") for (int k = 0; k < 2; ++k) dst[n][k] = *(const PG8_LAS bf16x8*)(lds + PG8_SB(b, h) + boff + n * 2048 + k * 1024); } while (0)
#define PG8_MMA(ai, bj, At, Bt) do { __builtin_amdgcn_s_setprio(1); _Pragma("unroll") for (int m = 0; m < 4; ++m) _Pragma("unroll") for (int n = 0; n < 2; ++n) _Pragma("unroll") for (int k = 0; k < 2; ++k) \
        acc[ai][bj][m][n] = __builtin_amdgcn_mfma_f32_16x16x32_bf16(Bt[n][k], At[m][k], acc[ai][bj][m][n], 0, 0, 0); __builtin_amdgcn_s_setprio(0); } while (0)
#define PG8_WAIT_V(n) asm volatile("s_waitcnt vmcnt(" #n ")" ::: "memory")
#define PG8_WAIT_L(n) asm volatile("s_waitcnt lgkmcnt(" #n ")" ::: "memory")
#define PG8_BAR __builtin_amdgcn_s_barrier()
#define PG8_SCHED __builtin_amdgcn_sched_barrier(0)
    Unit cur, nxt; int ui = 0;
    if (!S.next(0, cur)) return;
    f32x4 acc[2][2][4][2];
#pragma unroll
    for (int a = 0; a < 2; ++a)
#pragma unroll
        for (int b = 0; b < 2; ++b)
#pragma unroll
            for (int m = 0; m < 4; ++m)
#pragma unroll
                for (int n = 0; n < 2; ++n) acc[a][b][m][n] = (f32x4){0.f, 0.f, 0.f, 0.f};
    bf16x8 At[4][2], B0[2][2], B1[2][2];
    const char* cA = (const char*)g.A + (size_t)cur.pm * tstep; const char* cB = (const char*)g.Bt + (size_t)cur.pn * tstep;
    S.a_ready(cur);
    if constexpr (SP2) {
        PG8_STAGE(PG8_SB(0, 0), cB, voffB); PG8_STAGE(PG8_SB(0, 1), cB + hstep, voffB); PG8_STAGE(PG8_SA(0, 0), cA, voffA); PG8_STAGE(PG8_SA(0, 1), cA + hstep, voffA);
        if (wr == 1) PG8_BAR;
        PG8_WAIT_V(2); PG8_BAR;
        PG8_STAGE(PG8_SB(1, 0), cB + kstep, voffB); PG8_STAGE(PG8_SA(1, 0), cA + kstep, voffA); PG8_STAGE(PG8_SB(1, 1), cB + hstep + kstep, voffB);
        PG8_WAIT_V(6); PG8_BAR;
    } else {
        PG8_STAGE(PG8_SB(0, 0), cB, voffB); PG8_STAGE(PG8_SA(0, 0), cA, voffA); PG8_STAGE(PG8_SB(0, 1), cB + hstep, voffB); PG8_STAGE(PG8_SA(0, 1), cA + hstep, voffA);
        if (wr == 1) PG8_BAR;
        PG8_WAIT_V(4); PG8_BAR;
        PG8_STAGE(PG8_SB(1, 0), cB + kstep, voffB); PG8_STAGE(PG8_SA(1, 0), cA + kstep, voffA); PG8_STAGE(PG8_SB(1, 1), cB + hstep + kstep, voffB);
        PG8_WAIT_V(6); PG8_BAR;
    }
    for (;;) {
        const bool has_next = S.next(ui + 1, nxt);
        const char* nA = has_next ? (const char*)g.A + (size_t)nxt.pm * tstep : cA; const char* nB = has_next ? (const char*)g.Bt + (size_t)nxt.pn * tstep : cB;
        for (int t = 0; t < nt; t += 2) {
            const bool last = (t == nt - 2);
            const char* a1 = cA + (size_t)(t + 1) * kstep;
            const char* a2 = last ? nA : cA + (size_t)(t + 2) * kstep; const char* b2 = last ? nB : cB + (size_t)(t + 2) * kstep;
            const char* a3 = a2 + kstep; const char* b3 = b2 + kstep;
            if (last && has_next) S.a_ready(nxt);
            if constexpr (SP2) {
            PG8_LDB(B0, 0, 0); PG8_LDB(B1, 0, 1); PG8_SCHED; PG8_LDA(At, 0, 0); PG8_STAGE(PG8_SA(1, 1), a1 + hstep, voffA);
            PG8_WAIT_V(8); PG8_WAIT_L(0); PG8_BAR; PG8_MMA(0, 0, At, B0); PG8_MMA(0, 1, At, B1); PG8_BAR; PG8_SCHED;
            PG8_LDA(At, 0, 1); PG8_STAGE(PG8_SB(0, 0), b2, voffB); PG8_STAGE(PG8_SB(0, 1), b2 + hstep, voffB); PG8_STAGE(PG8_SA(0, 0), a2, voffA);
            PG8_WAIT_V(8); PG8_WAIT_L(0); PG8_BAR; PG8_MMA(1, 0, At, B0); PG8_MMA(1, 1, At, B1); PG8_BAR; PG8_SCHED;
            PG8_LDB(B0, 1, 0); PG8_LDB(B1, 1, 1); PG8_SCHED; PG8_LDA(At, 1, 0); PG8_STAGE(PG8_SA(0, 1), a2 + hstep, voffA);
            PG8_WAIT_V(8); PG8_WAIT_L(0); PG8_BAR; PG8_MMA(0, 0, At, B0); PG8_MMA(0, 1, At, B1); PG8_BAR; PG8_SCHED;
            PG8_LDA(At, 1, 1); PG8_STAGE(PG8_SB(1, 0), b3, voffB); PG8_STAGE(PG8_SB(1, 1), b3 + hstep, voffB); PG8_STAGE(PG8_SA(1, 0), a3, voffA);
            PG8_WAIT_V(8); PG8_WAIT_L(0); PG8_BAR; PG8_MMA(1, 0, At, B0); PG8_MMA(1, 1, At, B1); PG8_BAR; PG8_SCHED;
            } else {
            PG8_LDB(B0, 0, 0); PG8_SCHED; PG8_LDA(At, 0, 0); PG8_STAGE(PG8_SA(1, 1), a1 + hstep, voffA);
            PG8_WAIT_L(8); PG8_BAR; PG8_WAIT_L(0); PG8_MMA(0, 0, At, B0); PG8_BAR; PG8_SCHED;
            PG8_LDB(B1, 0, 1); PG8_STAGE(PG8_SB(0, 0), b2, voffB);
            PG8_BAR; PG8_WAIT_L(0); PG8_MMA(0, 1, At, B1); PG8_BAR;
            PG8_LDA(At, 0, 1); PG8_STAGE(PG8_SA(0, 0), a2, voffA);
            PG8_BAR; PG8_WAIT_L(0); PG8_MMA(1, 0, At, B0); PG8_BAR; PG8_SCHED;
            PG8_STAGE(PG8_SB(0, 1), b2 + hstep, voffB);
            PG8_WAIT_V(6); PG8_BAR; PG8_MMA(1, 1, At, B1); PG8_BAR;
            PG8_LDB(B0, 1, 0); PG8_SCHED; PG8_LDA(At, 1, 0); PG8_STAGE(PG8_SA(0, 1), a2 + hstep, voffA);
            PG8_WAIT_L(8); PG8_BAR; PG8_WAIT_L(0); PG8_MMA(0, 0, At, B0); PG8_BAR; PG8_SCHED;
            PG8_LDB(B1, 1, 1); PG8_STAGE(PG8_SB(1, 0), b3, voffB);
            PG8_BAR; PG8_WAIT_L(0); PG8_MMA(0, 1, At, B1); PG8_BAR;
            PG8_LDA(At, 1, 1); PG8_STAGE(PG8_SA(1, 0), a3, voffA);
            PG8_BAR; PG8_WAIT_L(0); PG8_MMA(1, 0, At, B0); PG8_BAR; PG8_SCHED;
            PG8_STAGE(PG8_SB(1, 1), b3 + hstep, voffB);
            PG8_WAIT_V(6); PG8_BAR; PG8_MMA(1, 1, At, B1); PG8_BAR;
            }
        }
        if constexpr (ALIGN_EPI) { if (wr == 0) PG8_BAR; }
        if constexpr (!Epi::AFTER_DRAIN) { E(acc, cur, wr, wc, fr, fq); S.done(cur); }
        if (!has_next) break;
#pragma unroll
        for (int a = 0; a < 2; ++a)
#pragma unroll
            for (int b = 0; b < 2; ++b)
#pragma unroll
                for (int m = 0; m < 4; ++m)
#pragma unroll
                    for (int n = 0; n < 2; ++n) acc[a][b][m][n] = (f32x4){0.f, 0.f, 0.f, 0.f};
        cur = nxt; cA = nA; cB = nB; ++ui;
        if constexpr (ALIGN_EPI) { if (wr == 1) PG8_BAR; }
    }
    PG8_WAIT_V(0);
    if constexpr (!ALIGN_EPI) { if (wr == 0) PG8_BAR; }
    PG8_BAR;
    if constexpr (Epi::AFTER_DRAIN) { E.fused(acc, cur, wr, wc, fr, fq, lds, wid, lane); S.done(cur); }
#undef PG8_SA
#undef PG8_SB
#undef PG8_STAGE
#undef PG8_LDA
#undef PG8_LDB
#undef PG8_MMA
#undef PG8_WAIT_V
#undef PG8_WAIT_L
#undef PG8_BAR
#undef PG8_SCHED
}
}

constexpr int NB = 4, SEQ = 4096, D = 1024, M = NB * SEQ, BW = 512, FF = 2816, NIN = 6144, NINF = 6152, DEPTH = 4, NWAVES = 8;
constexpr int NCH = SEQ / 64;
constexpr float ALPHA = 1.6817928305074292f, LN_EPS = 1e-5f, LOG2E = 1.4426950408889634f;
constexpr float QSCALE = 0.125f * LOG2E;
constexpr size_t MiB = 1u << 20;
constexpr size_t WS_WIN = 1 * MiB, WS_WBR = 13 * MiB, WS_WOUT = 16 * MiB, WS_WGU = 18 * MiB, WS_WD = 29 * MiB, WS_WGLU = 35 * MiB, WS_WFG = 35 * MiB + 512 * 1024;
constexpr size_t WS_KERN = 36 * MiB, WS_WB = 37 * MiB, WS_WDD = 45 * MiB, WS_LAMC = 53 * MiB, WS_WAX = 53 * MiB + 256 * 1024;
constexpr size_t WS_XN = 54 * MiB;
constexpr size_t WS_Z = 86 * MiB;
constexpr size_t WS_G = 182 * MiB;
constexpr size_t WS_Y = 278 * MiB;
constexpr size_t WS_YS = 326 * MiB;
constexpr size_t WS_YI = 342 * MiB;
constexpr size_t WS_S = 374 * MiB;
constexpr size_t WS_LOGF = 378 * MiB;
constexpr size_t WS_AE = 379 * MiB, WS_HE = 379 * MiB + 512 * 1024;
constexpr size_t WS_END = 380 * MiB;
constexpr int LDS_BYTES = 147456;

#define LAS __attribute__((address_space(3)))
typedef unsigned short bf16;
typedef unsigned v4u __attribute__((ext_vector_type(4)));
typedef unsigned v2u __attribute__((ext_vector_type(2)));
typedef float f32x4 __attribute__((ext_vector_type(4)));
typedef float f32x16 __attribute__((ext_vector_type(16)));
typedef short bf16x8 __attribute__((ext_vector_type(8)));
typedef short s16x4 __attribute__((ext_vector_type(4)));
#define LDS_WAIT() asm volatile("s_waitcnt lgkmcnt(0)" ::: "memory")

__device__ __forceinline__ unsigned f2bf(float f) { unsigned u = __builtin_bit_cast(unsigned, f); return (u + 0x7fffu + ((u >> 16) & 1u)) >> 16; }
__device__ __forceinline__ unsigned pk2(float lo, float hi) { return f2bf(lo) | (f2bf(hi) << 16); }
__device__ __forceinline__ float bf2f(unsigned short b) { return __builtin_bit_cast(float, (unsigned)b << 16); }
__device__ __forceinline__ float bflo(unsigned w) { return __builtin_bit_cast(float, w << 16); }
__device__ __forceinline__ float bfhi(unsigned w) { return __builtin_bit_cast(float, w & 0xffff0000u); }
__device__ __forceinline__ float sigmoidf_(float x) { return __builtin_amdgcn_rcpf(1.f + __expf(-x)); }
__device__ __forceinline__ float gelu_tanh(float x) { const float u = 0.7978845608028654f * (x + 0.044715f * x * x * x); const float t = 1.f - 2.f * __builtin_amdgcn_rcpf(__expf(2.f * u) + 1.f); return 0.5f * x * (1.f + t); }
__device__ __forceinline__ float wave_sum(float v) {
#pragma unroll
    for (int o = 1; o < 64; o <<= 1) v += __shfl_xor(v, o);
    return v;
}
__device__ __forceinline__ int crow(int r, int hi) { return (r & 3) + 8 * (r >> 2) + 4 * hi; }

struct EpiG1 {
    static constexpr bool PERM = true, AFTER_DRAIN = false;
    bf16* Z; bf16* Gt; const float* bgate;
    __device__ __forceinline__ void operator()(const f32x4 (&acc)[2][2][4][2], const pg8::Unit& u, int wr, int wc, int fr, int fq) const {
        const int row0 = u.pm * 256 + wr * 64 + fr, pn = u.pn;
#pragma unroll
        for (int ai = 0; ai < 2; ++ai)
#pragma unroll
            for (int m = 0; m < 4; ++m) {
                const int row = row0 + ai * 128 + m * 16;
#pragma unroll
                for (int bj = 0; bj < 2; ++bj) {
                    f32x4 v0 = acc[ai][bj][m][0], v1 = acc[ai][bj][m][1];
                    const int ct = bj * 128 + wc * 32 + 8 * fq;
                    bf16* dst;
                    if (pn < 2) { const int col = pn * 256 + ct; dst = Z + ((size_t)(col >> 4) * M + row) * 16 + (col & 15); }
                    else if (pn < 12) { const int t = (pn - 2) >> 1; const int col = (pn & 1) * 256 + ct; dst = Z + (size_t)(1 + t) * M * 512 + (size_t)row * 512 + col; if (t == 2) { v0 = v0 * QSCALE; v1 = v1 * QSCALE; } }
                    else { const int col = (pn - 12) * 256 + ct; dst = Gt + (size_t)row * 3072 + col; const f32x4 b0 = *(const f32x4*)(bgate + col), b1 = *(const f32x4*)(bgate + col + 4);
#pragma unroll
                        for (int j = 0; j < 4; ++j) { v0[j] = sigmoidf_(v0[j] + b0[j]); v1[j] = sigmoidf_(v1[j] + b1[j]); } }
                    v4u w; w.x = pk2(v0[0], v0[1]); w.y = pk2(v0[2], v0[3]); w.z = pk2(v1[0], v1[1]); w.w = pk2(v1[2], v1[3]);
                    *(v4u*)dst = w;
                }
                asm volatile("" ::: "memory");
            }
    }
};
struct OrderG2 {
    pg8::StaticOrder base;
    __device__ __forceinline__ bool next(int i, pg8::Unit& u) const { const int r = i / 3, k = i - 3 * r; pg8::Unit t; if (!base.next(r, t)) return false; u.pm = k * 64 + t.pm; u.pn = k * 4 + t.pn; return true; }
    __device__ __forceinline__ void a_ready(const pg8::Unit&) const {}
    __device__ __forceinline__ void done(const pg8::Unit&) const {}
};
struct EpiG2 {
    static constexpr bool PERM = true, AFTER_DRAIN = false;
    const bf16* Gt; float* GSF; bf16* GS;
    __device__ __forceinline__ void operator()(const f32x4 (&acc)[2][2][4][2], const pg8::Unit& u, int wr, int wc, int fr, int fq) const {
        const int k = u.pm >> 6, pm = u.pm & 63, pn = u.pn & 3;
        const int row0 = pm * 256 + wr * 64 + fr;
#pragma unroll
        for (int ai = 0; ai < 2; ++ai)
#pragma unroll
            for (int m = 0; m < 4; ++m) {
                const int row = row0 + ai * 128 + m * 16;
#pragma unroll
                for (int bj = 0; bj < 2; ++bj) {
                    const int col = pn * 256 + bj * 128 + wc * 32 + 8 * fq;
                    const v4u gw = *(const v4u*)(Gt + (size_t)row * 3072 + k * 1024 + col);
                    f32x4 v0 = acc[ai][bj][m][0], v1 = acc[ai][bj][m][1];
                    v0[0] *= bflo(gw.x); v0[1] *= bfhi(gw.x); v0[2] *= bflo(gw.y); v0[3] *= bfhi(gw.y);
                    v1[0] *= bflo(gw.z); v1[1] *= bfhi(gw.z); v1[2] *= bflo(gw.w); v1[3] *= bfhi(gw.w);
                    float* sp = GSF + (size_t)row * 1024 + col;
                    if (k > 0) { v0 = v0 + *(const f32x4*)sp; v1 = v1 + *(const f32x4*)(sp + 4); }
                    if (k < 2) { *(f32x4*)sp = v0; *(f32x4*)(sp + 4) = v1; }
                    else { v4u w; w.x = pk2(v0[0], v0[1]); w.y = pk2(v0[2], v0[3]); w.z = pk2(v1[0], v1[1]); w.w = pk2(v1[2], v1[3]); *(v4u*)(GS + (size_t)row * 1024 + col) = w; }
                }
                asm volatile("" ::: "memory");
            }
    }
};
struct EpiRes {
    static constexpr bool PERM = false, AFTER_DRAIN = false;
    float* X;
    __device__ __forceinline__ void operator()(const f32x4 (&acc)[2][2][4][2], const pg8::Unit& u, int wr, int wc, int fr, int fq) const {
        const int row0 = u.pm * 256 + wr * 64 + fr, col0 = u.pn * 256 + wc * 32 + 4 * fq;
#pragma unroll
        for (int ai = 0; ai < 2; ++ai)
#pragma unroll
            for (int m = 0; m < 4; ++m) { float* rowp = X + (size_t)(row0 + ai * 128 + m * 16) * 1024 + col0;
#pragma unroll
                for (int bj = 0; bj < 2; ++bj)
#pragma unroll
                    for (int n = 0; n < 2; ++n) { f32x4* p = (f32x4*)(rowp + bj * 128 + n * 16); *p = (*p) * ALPHA + acc[ai][bj][m][n]; }
                asm volatile("" ::: "memory"); }
    }
};
struct EpiSwiGlu {
    static constexpr bool PERM = true, AFTER_DRAIN = false;
    bf16* H;
    __device__ __forceinline__ void operator()(const f32x4 (&acc)[2][2][4][2], const pg8::Unit& u, int wr, int wc, int fr, int fq) const {
        const int row0 = u.pm * 256 + wr * 64 + fr;
#pragma unroll
        for (int ai = 0; ai < 2; ++ai)
#pragma unroll
            for (int m = 0; m < 4; ++m) {
                const int row = row0 + ai * 128 + m * 16;
#pragma unroll
                for (int bj = 0; bj < 2; ++bj) {
                    const f32x4 g = acc[ai][bj][m][0], up = acc[ai][bj][m][1]; float h[4];
#pragma unroll
                    for (int j = 0; j < 4; ++j) h[j] = g[j] * sigmoidf_(g[j]) * up[j];
                    const int col = u.pn * 128 + bj * 64 + wc * 16 + 4 * fq;
                    v2u w; w.x = pk2(h[0], h[1]); w.y = pk2(h[2], h[3]);
                    *(v2u*)(H + (size_t)row * FF + col) = w;
                }
                asm volatile("" ::: "memory");
            }
    }
};
struct EpiGlu {
    static constexpr bool PERM = true, AFTER_DRAIN = false;
    const bf16* YS; bf16* Y0; const float* bglu;
    __device__ __forceinline__ void operator()(const f32x4 (&acc)[2][2][4][2], const pg8::Unit& u, int wr, int wc, int fr, int fq) const {
        const int row0 = u.pm * 256 + wr * 64 + fr;
#pragma unroll
        for (int ai = 0; ai < 2; ++ai)
#pragma unroll
            for (int m = 0; m < 4; ++m) {
                const int row = row0 + ai * 128 + m * 16;
#pragma unroll
                for (int bj = 0; bj < 2; ++bj) {
                    const int col = u.pn * 256 + bj * 128 + wc * 32 + 8 * fq;
                    const v4u yw = *(const v4u*)(YS + (size_t)row * 512 + col);
                    const f32x4 b0 = *(const f32x4*)(bglu + col), b1 = *(const f32x4*)(bglu + col + 4);
                    const f32x4 a0 = acc[ai][bj][m][0], a1 = acc[ai][bj][m][1];
                    float o[8];
                    o[0] = bflo(yw.x) * sigmoidf_(a0[0] + b0[0]); o[1] = bfhi(yw.x) * sigmoidf_(a0[1] + b0[1]); o[2] = bflo(yw.y) * sigmoidf_(a0[2] + b0[2]); o[3] = bfhi(yw.y) * sigmoidf_(a0[3] + b0[3]);
                    o[4] = bflo(yw.z) * sigmoidf_(a1[0] + b1[0]); o[5] = bfhi(yw.z) * sigmoidf_(a1[1] + b1[1]); o[6] = bflo(yw.w) * sigmoidf_(a1[2] + b1[2]); o[7] = bfhi(yw.w) * sigmoidf_(a1[3] + b1[3]);
                    v4u w; w.x = pk2(o[0], o[1]); w.y = pk2(o[2], o[3]); w.z = pk2(o[4], o[5]); w.w = pk2(o[6], o[7]);
                    *(v4u*)(Y0 + (size_t)row * 512 + col) = w;
                }
                asm volatile("" ::: "memory");
            }
    }
};

struct Args { const float* in[30]; float* out; unsigned char* ws; };
enum { I_X = 0, I_WIN, I_BF, I_BGATE, I_ARE, I_AIM, I_LOGDT, I_BRE, I_BIM, I_CRE, I_CIM, I_SD, I_WGLU, I_BGLU, I_CONVW, I_CONVB, I_WA, I_BA, I_WX, I_BX, I_LAM, I_WBR, I_WOUT, I_LN1G, I_LN1B, I_WFG, I_WFU, I_WFD, I_LN2G, I_LN2B };

__device__ __forceinline__ unsigned char* WSP(const Args& a) { unsigned char* p = a.ws; asm volatile("" : "+s"(p)); return p; }
__device__ __forceinline__ const float* INP(const Args& a, int i) { asm volatile("" : "+s"(i)); return a.in[i]; }
__device__ __forceinline__ void tr_item(const float* W, int ldw, int K, int col_off, int nblk, bf16* WT, int mode, int row_off, LAS float* scr, int item, int lane) {
    const int kb = item / nblk, nb = item - kb * nblk, k0 = 64 * kb, n0 = 32 * nb;
#pragma unroll 8
    for (int i = 0; i < 32; ++i) { const int kk = 2 * i + (lane >> 5); scr[kk * 33 + (lane & 31)] = W[(size_t)(k0 + kk) * ldw + col_off + n0 + (lane & 31)]; }
    LDS_WAIT();
    const int c = lane & 7;
#pragma unroll
    for (int j = 0; j < 4; ++j) { const int n = (lane >> 3) + 8 * j; const LAS float* s = scr + (8 * c) * 33 + n;
        v4u o; o.x = pk2(s[0 * 33], s[1 * 33]); o.y = pk2(s[2 * 33], s[3 * 33]); o.z = pk2(s[4 * 33], s[5 * 33]); o.w = pk2(s[6 * 33], s[7 * 33]);
        const int ns = n0 + n; const int orow = (mode == 0) ? (row_off + ns) : (8 * (ns >> 2) + (ns & 3) + (mode == 2 ? 4 : 0));
        *(v4u*)(WT + (size_t)orow * K + k0 + 8 * c) = o; }
    LDS_WAIT();
}
__device__ __forceinline__ void cexp_pow(float are, float aim, float dt, int j, float& re, float& im) {
    const float mag = expf(are * dt * (float)j);
    double ang = (double)aim * (double)dt * (double)j;
    ang -= rint(ang * 0.15915494309189535) * 6.283185307179586;
    const float a = (float)ang;
    re = mag * cosf(a); im = mag * sinf(a);
}
__device__ __forceinline__ void convert_phase(const Args& a, int l, LAS unsigned char* lds, int gw, int NGW, int wave, int lane) {
    asm volatile("" : "+v"(lane)); asm volatile("" : "+s"(wave), "+s"(gw));
    unsigned char* ws = WSP(a);
    LAS float* scr = (LAS float*)(lds + wave * 16384);
    constexpr int I0 = 16 * 96, I1 = I0 + 16 * 96, I2 = I1 + 3 * 8 * 32, I3 = I2 + 16 * 32, I4 = I3 + 16 * 88, I5 = I4 + 16 * 88, I6 = I5 + 44 * 32, I7 = I6 + 8 * 16;
    for (int it = gw; it < I7; it += NGW) {
        if (it < I0) tr_item(INP(a, I_WIN) + (size_t)l * D * NINF, NINF, D, 0, 96, (bf16*)(ws + WS_WIN), 0, 0, scr, it, lane);
        else if (it < I1) tr_item(INP(a, I_WIN) + (size_t)l * D * NINF, NINF, D, 3080, 96, (bf16*)(ws + WS_WIN), 0, 3072, scr, it - I0, lane);
        else if (it < I2) { const int r = it - I1, k = r / 256; tr_item(INP(a, I_WBR) + (size_t)(l * 3 + k) * BW * D, D, BW, 0, 32, (bf16*)(ws + WS_WBR), 0, k * 1024, scr, r - k * 256, lane); }
        else if (it < I3) tr_item(INP(a, I_WOUT) + (size_t)l * D * D, D, D, 0, 32, (bf16*)(ws + WS_WOUT), 0, 0, scr, it - I2, lane);
        else if (it < I4) tr_item(INP(a, I_WFG) + (size_t)l * D * FF, FF, D, 0, 88, (bf16*)(ws + WS_WGU), 1, 0, scr, it - I3, lane);
        else if (it < I5) tr_item(INP(a, I_WFU) + (size_t)l * D * FF, FF, D, 0, 88, (bf16*)(ws + WS_WGU), 2, 0, scr, it - I4, lane);
        else if (it < I6) tr_item(INP(a, I_WFD) + (size_t)l * FF * D, D, FF, 0, 32, (bf16*)(ws + WS_WD), 0, 0, scr, it - I5, lane);
        else tr_item(INP(a, I_WGLU) + (size_t)l * BW * BW, BW, BW, 0, 16, (bf16*)(ws + WS_WGLU), 0, 0, scr, it - I6, lane);
    }
    { float* wfg = (float*)(ws + WS_WFG); const float* win = INP(a, I_WIN) + (size_t)l * D * NINF;
      for (int e = gw * 64 + lane; e < 8 * D; e += NGW * 64) { const int h = e >> 10, k = e & 1023; wfg[e] = win[(size_t)k * NINF + 3072 + h]; } }
    { bf16* wax = (bf16*)(ws + WS_WAX);
      for (int e = gw * 64 + lane; e < 8 * 2 * 64 * 64; e += NGW * 64) { const int h = e >> 13, gt = (e >> 12) & 1, j = (e >> 6) & 63, i = e & 63;
          const float* src = (gt ? INP(a, I_WX) : INP(a, I_WA)) + ((size_t)(l * 8 + h) * 64 + i) * 64 + j; wax[e] = (bf16)f2bf(*src); } }
    {
        bf16* KERN = (bf16*)(ws + WS_KERN); bf16* WB = (bf16*)(ws + WS_WB); bf16* WDD = (bf16*)(ws + WS_WDD); float* LAMC = (float*)(ws + WS_LAMC);
        LAS float* Tre = scr; LAS float* Tim = scr + 1024;
        for (int it = gw; it < 32 * 65; it += NGW) {
            const int g = it / 65, j = it - g * 65, p = lane;
            const float are = INP(a, I_ARE)[(l * 32 + g) * 64 + p], aim = INP(a, I_AIM)[(l * 32 + g) * 64 + p], dt = expf(INP(a, I_LOGDT)[l * 32 + g]);
            float lbr, lbi, er, ei;
            cexp_pow(are, aim, dt, 1, lbr, lbi);
            cexp_pow(are, aim, dt, j, er, ei);
            const float nr = lbr - 1.f, ni = lbi, den = 1.f / (are * are + aim * aim);
            const float cfr = (nr * are + ni * aim) * den, cfi = (ni * are - nr * aim) * den;
            if (j == 64) { LAMC[(g * 64 + p) * 2] = er; LAMC[(g * 64 + p) * 2 + 1] = ei; }
            const float* cre = INP(a, I_CRE) + (size_t)(l * 32 + g) * 16 * 64; const float* cim = INP(a, I_CIM) + (size_t)(l * 32 + g) * 16 * 64;
            if (j >= 1) {
                const int t = j - 1;
#pragma unroll 4
                for (int c = 0; c < 16; ++c) { const float cr = cre[c * 64 + p], ci = cim[c * 64 + p];
                    bf16* d = WDD + ((size_t)g * 1024 + t * 16 + c) * 128 + p;
                    d[0] = (bf16)f2bf(cr * er - ci * ei); d[64] = (bf16)f2bf(-(cr * ei + ci * er)); }
            }
            if (j <= 63) {
                const f32x4* brp = (const f32x4*)(INP(a, I_BRE) + ((size_t)(l * 32 + g) * 64 + p) * 16); const f32x4* bip = (const f32x4*)(INP(a, I_BIM) + ((size_t)(l * 32 + g) * 64 + p) * 16);
                const int s = 63 - j;
                bf16* wbr = WB + ((size_t)g * 128 + p) * 1024 + s * 16; bf16* wbi = WB + ((size_t)g * 128 + 64 + p) * 1024 + s * 16;
#pragma unroll
                for (int q = 0; q < 4; ++q) { const f32x4 br = brp[q], bi = bip[q]; f32x4 tr, ti;
#pragma unroll
                    for (int e = 0; e < 4; ++e) { const float bbr = cfr * br[e] - cfi * bi[e], bbi = cfr * bi[e] + cfi * br[e]; tr[e] = er * bbr - ei * bbi; ti[e] = er * bbi + ei * bbr; }
                    *(LAS f32x4*)(Tre + p * 16 + 4 * q) = tr; *(LAS f32x4*)(Tim + p * 16 + 4 * q) = ti;
                    v2u w; w.x = pk2(tr[0], tr[1]); w.y = pk2(tr[2], tr[3]); *(v2u*)(wbr + 4 * q) = w;
                    w.x = pk2(ti[0], ti[1]); w.y = pk2(ti[2], ti[3]); *(v2u*)(wbi + 4 * q) = w; }
                LDS_WAIT();
                const int c = lane >> 2, cq = lane & 3; f32x4 acc = {0.f, 0.f, 0.f, 0.f};
#pragma unroll 4
                for (int p4 = 0; p4 < 16; ++p4) { const f32x4 cr = *(const f32x4*)(cre + c * 64 + 4 * p4), ci = *(const f32x4*)(cim + c * 64 + 4 * p4);
#pragma unroll
                    for (int e = 0; e < 4; ++e) { const f32x4 tr = *(const LAS f32x4*)(Tre + (4 * p4 + e) * 16 + 4 * cq), ti = *(const LAS f32x4*)(Tim + (4 * p4 + e) * 16 + 4 * cq); acc = acc + tr * cr[e] - ti * ci[e]; } }
                v2u w; w.x = pk2(acc[0], acc[1]); w.y = pk2(acc[2], acc[3]);
                *(v2u*)(KERN + (((size_t)g * 64 + j) * 16 + c) * 16 + 4 * cq) = w;
                LDS_WAIT();
            }
        }
    }
}

__device__ __forceinline__ void ln_phase(const float* src, float* X, bf16* XN, const float* gam, const float* bet, int gw, int NGW, int lane) {
    asm volatile("" : "+v"(lane)); asm volatile("" : "+s"(gw));
    for (int m = gw; m < M; m += NGW) {
        const f32x4* xr = (const f32x4*)(src + (size_t)m * D) + lane;
        f32x4 v[4];
#pragma unroll
        for (int j = 0; j < 4; ++j) v[j] = xr[64 * j];
        if (gam) {
            float s = 0.f;
#pragma unroll
            for (int j = 0; j < 4; ++j) s += (v[j].x + v[j].y) + (v[j].z + v[j].w);
            const float mean = wave_sum(s) * (1.f / D); float s2 = 0.f;
#pragma unroll
            for (int j = 0; j < 4; ++j) { v[j] = v[j] - mean; s2 += (v[j].x * v[j].x + v[j].y * v[j].y) + (v[j].z * v[j].z + v[j].w * v[j].w); }
            const float rstd = 1.f / sqrtf(wave_sum(s2) * (1.f / D) + LN_EPS);
#pragma unroll
            for (int j = 0; j < 4; ++j) { const f32x4 gg = *((const f32x4*)gam + lane + 64 * j), bb = *((const f32x4*)bet + lane + 64 * j); v[j] = v[j] * rstd * gg + bb; }
        }
        f32x4* xo = (f32x4*)(X + (size_t)m * D) + lane; v2u* o8 = (v2u*)(XN + (size_t)m * D) + lane;
#pragma unroll
        for (int j = 0; j < 4; ++j) { xo[64 * j] = v[j]; v2u w; w.x = pk2(v[j].x, v[j].y); w.y = pk2(v[j].z, v[j].w); o8[64 * j] = w; }
    }
}

__device__ __forceinline__ void lru_local_item(const Args& a, int l, int item, LAS unsigned char* wl, int lane) {
    unsigned char* ws = WSP(a);
    const int h = item & 7, n = (item >> 3) & 63, b = item >> 9;
    const int ch = h * 64 + lane, fr = lane & 15, fq = lane >> 4;
    const bf16* XL = (const bf16*)(ws + WS_Z) + (size_t)1 * M * 512;
    bf16* HL = (bf16*)(ws + WS_XN); bf16* PP = HL + (size_t)M * 512;
    const bf16* WAX = (const bf16*)(ws + WS_WAX);
    bf16x8 Bf[2][4][2];
#pragma unroll
    for (int gt = 0; gt < 2; ++gt)
#pragma unroll
        for (int nt = 0; nt < 4; ++nt)
#pragma unroll
            for (int ks = 0; ks < 2; ++ks) Bf[gt][nt][ks] = *(const bf16x8*)(WAX + ((size_t)((h * 2 + gt) * 64 + 16 * nt + fr)) * 64 + 32 * ks + 8 * fq);
    const float* cwp = INP(a, I_CONVW) + (size_t)l * 4 * BW;
    const float cw0 = cwp[ch], cw1 = cwp[BW + ch], cw2 = cwp[2 * BW + ch], cw3 = cwp[3 * BW + ch], cb = INP(a, I_CONVB)[l * BW + ch];
    const float lamv = INP(a, I_LAM)[l * BW + ch];
    const float c8 = -8.f * log1pf(expf(-lamv));
    const float ba = INP(a, I_BA)[l * BW + ch], bx = INP(a, I_BX)[l * BW + ch];
    const size_t tok0 = (size_t)b * SEQ + n * 64;
    float xm3 = 0.f, xm2 = 0.f, xm1 = 0.f;
    if (n > 0) { xm3 = bf2f(XL[(tok0 - 3) * 512 + ch]); xm2 = bf2f(XL[(tok0 - 2) * 512 + ch]); xm1 = bf2f(XL[(tok0 - 1) * 512 + ch]); }
    LAS bf16* XC = (LAS bf16*)(wl + 2048);
    LAS float* RG = (LAS float*)(wl + 4352);
    float hloc = 0.f, P = 1.f;
    for (int mt = 0; mt < 4; ++mt) {
        float xc[16];
#pragma unroll
        for (int i = 0; i < 16; ++i) { const float xv = bf2f(XL[(tok0 + mt * 16 + i) * 512 + ch]); xc[i] = cb + cw0 * xm3 + cw1 * xm2 + cw2 * xm1 + cw3 * xv; xm3 = xm2; xm2 = xm1; xm1 = xv; XC[i * 72 + lane] = (bf16)f2bf(xc[i]); }
        LDS_WAIT();
        const bf16x8 A0 = *(const LAS bf16x8*)(XC + fr * 72 + 8 * fq), A1 = *(const LAS bf16x8*)(XC + fr * 72 + 32 + 8 * fq);
#pragma unroll
        for (int gt = 0; gt < 2; ++gt)
#pragma unroll
            for (int nt = 0; nt < 4; ++nt) { f32x4 acc = {0.f, 0.f, 0.f, 0.f};
                acc = __builtin_amdgcn_mfma_f32_16x16x32_bf16(A0, Bf[gt][nt][0], acc, 0, 0, 0);
                acc = __builtin_amdgcn_mfma_f32_16x16x32_bf16(A1, Bf[gt][nt][1], acc, 0, 0, 0);
#pragma unroll
                for (int e = 0; e < 4; ++e) RG[(gt * 16 + 4 * fq + e) * 64 + 16 * nt + fr] = acc[e]; }
        LDS_WAIT();
#pragma unroll
        for (int i = 0; i < 16; ++i) {
            const float ra = RG[i * 64 + lane] + ba, rx = RG[(16 + i) * 64 + lane] + bx;
            const float r = 1.f / (1.f + expf(-ra)), ig = 1.f / (1.f + expf(-rx));
            const float la = c8 * r, av = expf(la), mult = sqrtf(-expm1f(2.f * la));
            hloc = av * hloc + mult * ig * xc[i]; P *= av;
            const size_t o = (tok0 + mt * 16 + i) * 512 + ch;
            HL[o] = (bf16)f2bf(hloc); PP[o] = (bf16)f2bf(P);
        }
        LDS_WAIT();
    }
    float* AE = (float*)(ws + WS_AE); float* HE = (float*)(ws + WS_HE);
    AE[(size_t)(b * NCH + n) * 512 + ch] = P; HE[(size_t)(b * NCH + n) * 512 + ch] = hloc;
}
__device__ __forceinline__ void s5_intra_item(const Args& a, int item, LAS unsigned char* wl, int lane) {
    unsigned char* ws = WSP(a);
    const int g = item & 31, n = (item >> 5) & 63, b = item >> 11;
    const bf16* U2 = (const bf16*)(ws + WS_Z); const bf16* KERN = (const bf16*)(ws + WS_KERN); float* YI = (float*)(ws + WS_YI);
    LAS bf16* ut = (LAS bf16*)wl;
    const size_t tok0 = (size_t)b * SEQ + n * 64;
    { const v4u* src = (const v4u*)(U2 + ((size_t)g * M + tok0 + lane) * 16); const v4u x0 = src[0], x1 = src[1];
      *(LAS v4u*)(ut + (64 + lane) * 16) = x0; *(LAS v4u*)(ut + (64 + lane) * 16 + 8) = x1; }
    LDS_WAIT();
    const int fr = lane & 15, fq = lane >> 4;
    f32x4 acc[4];
#pragma unroll
    for (int mt = 0; mt < 4; ++mt) {
        acc[mt] = (f32x4){0.f, 0.f, 0.f, 0.f};
#pragma unroll 2
        for (int slab = 0; slab < 8 * (mt + 1); ++slab) {
            const int j = 2 * slab + (fq >> 1);
            const bf16x8 A = *(const LAS bf16x8*)(ut + (64 + 16 * mt + fr - j) * 16 + 8 * (fq & 1));
            const bf16x8 B = *(const bf16x8*)(KERN + (((size_t)g * 64 + j) * 16 + fr) * 16 + 8 * (fq & 1));
            acc[mt] = __builtin_amdgcn_mfma_f32_16x16x32_bf16(A, B, acc[mt], 0, 0, 0);
        }
    }
#pragma unroll
    for (int mt = 0; mt < 4; ++mt)
#pragma unroll
        for (int i = 0; i < 4; ++i) YI[(tok0 + 16 * mt + 4 * fq + i) * 512 + g * 16 + fr] = acc[mt][i];
    LDS_WAIT();
}
__device__ __forceinline__ void s5_state_item(const Args& a, int item, int lane) {
    unsigned char* ws = WSP(a);
    const int rt = item & 15, g = item >> 4, b = rt >> 2, n0 = 16 * (rt & 3);
    const bf16* U2 = (const bf16*)(ws + WS_Z); const bf16* WB = (const bf16*)(ws + WS_WB); float* S = (float*)(ws + WS_S);
    const int fr = lane & 15, fq = lane >> 4;
    f32x4 acc[8];
#pragma unroll
    for (int nt = 0; nt < 8; ++nt) acc[nt] = (f32x4){0.f, 0.f, 0.f, 0.f};
#pragma unroll 2
    for (int slab = 0; slab < 32; ++slab) {
        const int s = 2 * slab + (fq >> 1);
        const size_t tok = (size_t)b * SEQ + (n0 + fr) * 64 + s;
        const bf16x8 A = *(const bf16x8*)(U2 + ((size_t)g * M + tok) * 16 + 8 * (fq & 1));
#pragma unroll
        for (int nt = 0; nt < 8; ++nt) { const bf16x8 B = *(const bf16x8*)(WB + ((size_t)g * 128 + 16 * nt + fr) * 1024 + 32 * slab + 8 * fq); acc[nt] = __builtin_amdgcn_mfma_f32_16x16x32_bf16(A, B, acc[nt], 0, 0, 0); }
    }
#pragma unroll
    for (int nt = 0; nt < 8; ++nt)
#pragma unroll
        for (int i = 0; i < 4; ++i) S[((size_t)(b * NCH + n0 + 4 * fq + i) * 32 + g) * 128 + 16 * nt + fr] = acc[nt][i];
}
__device__ __forceinline__ void fg_row(const Args& a, int l, int m, LAS unsigned char* lds, int lane) {
    const f32x4* xr = (const f32x4*)(a.out + (size_t)m * D) + lane;
    f32x4 v[4];
#pragma unroll
    for (int j = 0; j < 4; ++j) v[j] = xr[64 * j];
    const LAS f32x4* wf = (const LAS f32x4*)lds + lane;
    float mine = 0.f;
#pragma unroll
    for (int h = 0; h < 8; ++h) { float s = 0.f;
#pragma unroll
        for (int j = 0; j < 4; ++j) { const f32x4 w = wf[h * 256 + 64 * j]; s += (v[j].x * w.x + v[j].y * w.y) + (v[j].z * w.z + v[j].w * w.w); }
        s = wave_sum(s); if (lane == h) mine = s; asm volatile("" ::: "memory"); }
    if (lane < 8) { const float z = mine + INP(a, I_BF)[l * 8 + lane]; const float lf = fminf(z, 0.f) - log1pf(expf(-fabsf(z)));
        const int b = m >> 12, t = m & 4095; ((float*)(WSP(a) + WS_LOGF))[(size_t)(b * 8 + lane) * SEQ + t] = lf * LOG2E; }
}
__device__ __forceinline__ void slot_a(const Args& a, int l, LAS unsigned char* lds, int gw, int NGW, int wave, int lane, int tid) {
    asm volatile("" : "+v"(lane), "+v"(tid)); asm volatile("" : "+s"(wave), "+s"(gw));
    LAS unsigned char* wl = lds + 32768 + wave * 12800;
    { const f32x4* src = (const f32x4*)(WSP(a) + WS_WFG); LAS f32x4* dst = (LAS f32x4*)lds; for (int i = tid; i < 2048; i += 512) dst[i] = src[i]; }
    { LAS bf16* ut = (LAS bf16*)wl; const v4u z = {0u, 0u, 0u, 0u}; *(LAS v4u*)(ut + lane * 16) = z; *(LAS v4u*)(ut + lane * 16 + 8) = z; }
    LDS_WAIT(); __syncthreads();
#ifndef NO_LRU
    for (int it = gw; it < NB * NCH * 8; it += NGW) lru_local_item(a, l, it, wl, lane);
#endif
#ifndef NO_S5
    for (int it = gw; it < NB * NCH * 32; it += NGW) s5_intra_item(a, it, wl, lane);
    for (int it = gw; it < 4 * 512; it += NGW) if ((it & 3) == 0) s5_state_item(a, it >> 2, lane);
#endif
#ifndef NO_FG
    for (int m = gw; m < M; m += NGW) fg_row(a, l, m, lds, lane);
#endif
}

__device__ __forceinline__ void s5_carry_item(const Args& a, int l, int item, LAS unsigned char* lds, int wave, int lane) {
    unsigned char* ws = WSP(a);
    const int rt = item & 15, g = item >> 4, b = rt >> 2, n0 = 16 * (rt & 3);
    const bf16* U2 = (const bf16*)(ws + WS_Z); const bf16* WDD = (const bf16*)(ws + WS_WDD); const float* S = (const float*)(ws + WS_S);
    const float* YI = (const float*)(ws + WS_YI); bf16* YS = (bf16*)(ws + WS_YS);
    LAS bf16* Hs = (LAS bf16*)(lds + 65536 + wave * 4096);
    const float lcr = ((const float*)(ws + WS_LAMC))[(g * 64 + lane) * 2], lci = ((const float*)(ws + WS_LAMC))[(g * 64 + lane) * 2 + 1];
    float hr = 0.f, hi_ = 0.f;
    for (int m = 0; m < n0 + 16; ++m) {
        if (m >= n0) { Hs[(m - n0) * 128 + lane] = (bf16)f2bf(hr); Hs[(m - n0) * 128 + 64 + lane] = (bf16)f2bf(hi_); }
        const float* sp = S + ((size_t)(b * NCH + m) * 32 + g) * 128;
        const float sr = sp[lane], si = sp[64 + lane];
        const float nr = lcr * hr - lci * hi_ + sr, ni = lcr * hi_ + lci * hr + si; hr = nr; hi_ = ni;
    }
    LDS_WAIT();
    const int fr = lane & 15, fq = lane >> 4;
    bf16x8 Af[4];
#pragma unroll
    for (int s = 0; s < 4; ++s) Af[s] = *(const LAS bf16x8*)(Hs + fr * 128 + 32 * s + 8 * fq);
    const float dsk = INP(a, I_SD)[l * BW + g * 16 + fr];
#pragma unroll 2
    for (int nt = 0; nt < 64; ++nt) {
        f32x4 acc = {0.f, 0.f, 0.f, 0.f};
#pragma unroll
        for (int s = 0; s < 4; ++s) { const bf16x8 B = *(const bf16x8*)(WDD + ((size_t)g * 1024 + 16 * nt + fr) * 128 + 32 * s + 8 * fq); acc = __builtin_amdgcn_mfma_f32_16x16x32_bf16(Af[s], B, acc, 0, 0, 0); }
#pragma unroll
        for (int i = 0; i < 4; ++i) { const size_t tok = (size_t)b * SEQ + (n0 + 4 * fq + i) * 64 + nt;
            const float uu = bf2f(U2[((size_t)g * M + tok) * 16 + fr]);
            const float y = YI[tok * 512 + g * 16 + fr] + acc[i] + dsk * uu;
            YS[tok * 512 + g * 16 + fr] = (bf16)f2bf(gelu_tanh(y)); }
    }
    LDS_WAIT();
}
__device__ __forceinline__ void lru_apply_item(const Args& a, int item, int lane) {
    unsigned char* ws = WSP(a);
    const int h = item & 7, n = (item >> 3) & 63, b = item >> 9;
    const int ch = h * 64 + lane;
    const bf16* HL = (const bf16*)(ws + WS_XN); const bf16* PP = HL + (size_t)M * 512;
    const bf16* GL = (const bf16*)(ws + WS_Z) + (size_t)2 * M * 512;
    bf16* Y1 = (bf16*)(ws + WS_Y) + (size_t)M * 512;
    const float* AE = (const float*)(ws + WS_AE); const float* HE = (const float*)(ws + WS_HE);
    float hin = 0.f;
    for (int m = 0; m < n; ++m) hin = AE[(size_t)(b * NCH + m) * 512 + ch] * hin + HE[(size_t)(b * NCH + m) * 512 + ch];
    const size_t tok0 = (size_t)b * SEQ + n * 64;
#pragma unroll 8
    for (int t = 0; t < 64; ++t) { const size_t o = (tok0 + t) * 512 + ch;
        const float hv = bf2f(HL[o]) + bf2f(PP[o]) * hin;
        Y1[o] = (bf16)f2bf(gelu_tanh(bf2f(GL[o])) * hv); }
}
__device__ __forceinline__ void attn_pair(const Args& a, int b, int h, int s, LAS unsigned char* lds, int wave, int lane, int tid) {
    unsigned char* ws = WSP(a);
    const bf16* Q = (const bf16*)(ws + WS_Z) + (size_t)3 * M * 512; const bf16* K = Q + (size_t)M * 512; const bf16* V = K + (size_t)M * 512;
    bf16* O = (bf16*)(ws + WS_Y) + (size_t)2 * M * 512;
    LAS float* cum = (LAS float*)lds; LAS bf16* Ks = (LAS bf16*)(lds + 16384); LAS bf16* Vt = (LAS bf16*)(lds + 16384 + 9216); LAS float* wsum = (LAS float*)(lds + 16384 + 18432);
    const int r32 = lane & 31, hi = lane >> 5;
    __syncthreads();
    {
        const float* src = (const float*)(ws + WS_LOGF) + (size_t)(b * 8 + h) * SEQ + tid * 8;
        const f32x4 a0 = *(const f32x4*)src, a1 = *(const f32x4*)(src + 4);
        float v[8] = {a0.x, a0.y, a0.z, a0.w, a1.x, a1.y, a1.z, a1.w};
#pragma unroll
        for (int i = 1; i < 8; ++i) v[i] += v[i - 1];
        float incl = v[7];
#pragma unroll
        for (int o = 1; o < 64; o <<= 1) { const float t = __shfl_up(incl, o); if (lane >= o) incl += t; }
        if (lane == 63) wsum[wave] = incl;
        LDS_WAIT(); __syncthreads();
        float off = incl - v[7];
        for (int w = 0; w < wave; ++w) off += wsum[w];
        f32x4 o0 = {v[0] + off, v[1] + off, v[2] + off, v[3] + off}, o1 = {v[4] + off, v[5] + off, v[6] + off, v[7] + off};
        *(LAS f32x4*)(cum + tid * 8) = o0; *(LAS f32x4*)(cum + tid * 8 + 4) = o1;
    }
    LDS_WAIT(); __syncthreads();
    for (int uu = 0; uu < 2; ++uu) {
        const int qb = uu == 0 ? s : 15 - s, q0 = qb * 256;
        const int qrow = q0 + wave * 32 + r32;
        const size_t qtok = (size_t)b * SEQ + qrow;
        bf16x8 qf[4];
#pragma unroll
        for (int ds = 0; ds < 4; ++ds) qf[ds] = *(const bf16x8*)(Q + qtok * 512 + h * 64 + ds * 16 + hi * 8);
        const float cq = cum[qrow];
        float mrun = -1e30f, lrun = 0.f;
        f32x16 o[2];
#pragma unroll
        for (int r = 0; r < 16; ++r) { o[0][r] = 0.f; o[1][r] = 0.f; }
        const int NT = 4 * (qb + 1);
        for (int j = 0; j < NT; ++j) {
            __syncthreads();
            { const int row = tid >> 3, chk = tid & 7; const size_t tok = (size_t)b * SEQ + 64 * j + row;
              const v4u kk = *(const v4u*)(K + tok * 512 + h * 64 + chk * 8); *(LAS v4u*)(Ks + row * 72 + chk * 8) = kk;
              const v4u vv = *(const v4u*)(V + tok * 512 + h * 64 + chk * 8);
              LAS bf16* vd = Vt + (chk * 8) * 72 + row;
              vd[0] = (bf16)(vv.x & 0xffffu); vd[72] = (bf16)(vv.x >> 16); vd[144] = (bf16)(vv.y & 0xffffu); vd[216] = (bf16)(vv.y >> 16);
              vd[288] = (bf16)(vv.z & 0xffffu); vd[360] = (bf16)(vv.z >> 16); vd[432] = (bf16)(vv.w & 0xffffu); vd[504] = (bf16)(vv.w >> 16); }
            LDS_WAIT(); __syncthreads();
            if (64 * j <= q0 + wave * 32 + 31) {
                f32x16 p0, p1;
#pragma unroll
                for (int r = 0; r < 16; ++r) { p0[r] = 0.f; p1[r] = 0.f; }
#pragma unroll
                for (int ds = 0; ds < 4; ++ds) {
                    const bf16x8 k0 = *(const LAS bf16x8*)(Ks + r32 * 72 + ds * 16 + hi * 8);
                    const bf16x8 k1 = *(const LAS bf16x8*)(Ks + (32 + r32) * 72 + ds * 16 + hi * 8);
                    p0 = __builtin_amdgcn_mfma_f32_32x32x16_bf16(k0, qf[ds], p0, 0, 0, 0);
                    p1 = __builtin_amdgcn_mfma_f32_32x32x16_bf16(k1, qf[ds], p1, 0, 0, 0);
                }
                const bool diag = (64 * j + 63 > q0 + wave * 32);
                float mx = -1e30f;
#pragma unroll
                for (int r4 = 0; r4 < 4; ++r4) {
                    const int kvb = 64 * j + 8 * r4 + 4 * hi;
                    const f32x4 c0 = *(const LAS f32x4*)(cum + kvb), c1 = *(const LAS f32x4*)(cum + kvb + 32);
#pragma unroll
                    for (int e = 0; e < 4; ++e) { const int r = 4 * r4 + e;
                        float s0 = p0[r] + (cq - c0[e]), s1 = p1[r] + (cq - c1[e]);
                        if (diag) { if (kvb + e > qrow) s0 = -1e30f; if (kvb + e + 32 > qrow) s1 = -1e30f; }
                        p0[r] = s0; p1[r] = s1; mx = fmaxf(mx, fmaxf(s0, s1)); }
                }
                mx = fmaxf(mx, __shfl_xor(mx, 32));
                const float mnew = fmaxf(mrun, mx), alpha = __builtin_amdgcn_exp2f(mrun - mnew);
                float psum = 0.f;
#pragma unroll
                for (int r = 0; r < 16; ++r) { p0[r] = __builtin_amdgcn_exp2f(p0[r] - mnew); p1[r] = __builtin_amdgcn_exp2f(p1[r] - mnew); psum += p0[r] + p1[r]; }
                lrun = lrun * alpha + psum; mrun = mnew;
#pragma unroll
                for (int r = 0; r < 16; ++r) { o[0][r] *= alpha; o[1][r] *= alpha; }
                bf16x8 pk[4];
#pragma unroll
                for (int sl = 0; sl < 4; ++sl) {
                    v4u w;
                    if (sl < 2) { const int r0 = 8 * (sl & 1); w.x = pk2(p0[r0], p0[r0 + 1]); w.y = pk2(p0[r0 + 2], p0[r0 + 3]); w.z = pk2(p0[r0 + 4], p0[r0 + 5]); w.w = pk2(p0[r0 + 6], p0[r0 + 7]); }
                    else { const int r0 = 8 * (sl & 1); w.x = pk2(p1[r0], p1[r0 + 1]); w.y = pk2(p1[r0 + 2], p1[r0 + 3]); w.z = pk2(p1[r0 + 4], p1[r0 + 5]); w.w = pk2(p1[r0 + 6], p1[r0 + 7]); }
                    pk[sl] = __builtin_bit_cast(bf16x8, w);
                }
#pragma unroll
                for (int db = 0; db < 2; ++db)
#pragma unroll
                    for (int sl = 0; sl < 4; ++sl) {
                        const LAS bf16* vp = Vt + (32 * db + r32) * 72 + 16 * sl + 4 * hi;
                        const v2u lo = *(const LAS v2u*)vp, hh = *(const LAS v2u*)(vp + 8);
                        v4u w; w.x = lo.x; w.y = lo.y; w.z = hh.x; w.w = hh.y;
                        o[db] = __builtin_amdgcn_mfma_f32_32x32x16_bf16(__builtin_bit_cast(bf16x8, w), pk[sl], o[db], 0, 0, 0);
                    }
            }
        }
        lrun += __shfl_xor(lrun, 32);
        const float inv = 1.f / lrun;
#pragma unroll
        for (int db = 0; db < 2; ++db)
#pragma unroll
            for (int r4 = 0; r4 < 4; ++r4) { const int d = 32 * db + 8 * r4 + 4 * hi;
                v2u w; w.x = pk2(o[db][4 * r4] * inv, o[db][4 * r4 + 1] * inv); w.y = pk2(o[db][4 * r4 + 2] * inv, o[db][4 * r4 + 3] * inv);
                *(v2u*)(O + qtok * 512 + h * 64 + d) = w; }
    }
}
__device__ __forceinline__ void slot_b(const Args& a, int l, LAS unsigned char* lds, int gw, int NGW, int vcu, int G, int wave, int lane, int tid) {
    asm volatile("" : "+v"(lane), "+v"(tid)); asm volatile("" : "+s"(wave), "+s"(gw), "+s"(vcu));
#ifndef NO_B12
    for (int it = gw; it < NB * NCH * 8; it += NGW) lru_apply_item(a, it, lane);
    for (int it = gw; it < 4 * 512; it += NGW) if ((it & 3) == 0) s5_carry_item(a, l, it >> 2, lds, wave, lane);
#endif
#ifndef NO_ATTN
    for (int p = vcu; p < 256; p += G) attn_pair(a, p >> 6, (p >> 3) & 7, p & 7, lds, wave, lane, tid);
#endif
}

template <class Epi, class Sched, bool A_, bool B_> __device__ __forceinline__ void gemm_stub(LAS unsigned char*, const pg8::Gemm, const Sched&, const Epi&) {}
#if defined(NO_GEMM) || defined(NO_G1)
#define GEMMCALL_G1 gemm_stub
#else
#define GEMMCALL_G1 pg8::gemm_phase
#endif
#if defined(NO_GEMM) || defined(NO_GLU)
#define GEMMCALL_GLU gemm_stub
#else
#define GEMMCALL_GLU pg8::gemm_phase
#endif
#if defined(NO_GEMM) || defined(NO_G2)
#define GEMMCALL_G2 gemm_stub
#else
#define GEMMCALL_G2 pg8::gemm_phase
#endif
#if defined(NO_GEMM) || defined(NO_G3)
#define GEMMCALL_G3 gemm_stub
#else
#define GEMMCALL_G3 pg8::gemm_phase
#endif
#if defined(NO_GEMM) || defined(NO_G4)
#define GEMMCALL_G4 gemm_stub
#else
#define GEMMCALL_G4 pg8::gemm_phase
#endif
#if defined(NO_GEMM) || defined(NO_G5)
#define GEMMCALL_G5 gemm_stub
#else
#define GEMMCALL_G5 pg8::gemm_phase
#endif
#ifdef FAKE_SYNC
#define GRIDSYNC() __syncthreads()
#else
#define GRIDSYNC() grid.sync()
#endif
__global__ void __launch_bounds__(NWAVES * 64, 2) fwd_kernel(Args a) {
    extern __shared__ __attribute__((aligned(16))) unsigned char lds_raw[];
    cg::grid_group grid = cg::this_grid();
    LAS unsigned char* lds = (LAS unsigned char*)lds_raw;
    const int tid = threadIdx.x, lane = tid & 63, wave = __builtin_amdgcn_readfirstlane(tid >> 6);
    const int G = gridDim.x, bx = blockIdx.x;
    const int vcu = (G % 8 == 0) ? (bx % 8) * (G / 8) + bx / 8 : bx;
    const int gw = bx * NWAVES + wave, NGW = G * NWAVES;
    unsigned char* ws0 = WSP(a);
    bf16* XN0 = (bf16*)(ws0 + WS_XN);

    ln_phase(INP(a, I_X), a.out, XN0, nullptr, nullptr, gw, NGW, lane);
#ifndef NO_CONV
    convert_phase(a, 0, lds, gw, NGW, wave, lane);
#endif
    GRIDSYNC();

    for (int l = 0; l < DEPTH; ++l) {
        {
            unsigned char* ws = WSP(a); bf16* XN = (bf16*)(ws + WS_XN); (void)XN;
            pg8::Gemm g{XN, (const bf16*)(ws + WS_WIN), M, NIN, D}; pg8::StaticOrder S; S.init(M, NIN, G, bx);
            EpiG1 E{(bf16*)(ws + WS_Z), (bf16*)(ws + WS_G), INP(a, I_BGATE) + (size_t)l * 3072};
            GEMMCALL_G1<EpiG1, pg8::StaticOrder, true, true>(lds, g, S, E);
        }
        GRIDSYNC();
        slot_a(a, l, lds, gw, NGW, wave, lane, tid);
        GRIDSYNC();
        slot_b(a, l, lds, gw, NGW, vcu, G, wave, lane, tid);
        GRIDSYNC();
        {
            unsigned char* ws = WSP(a); bf16* XN = (bf16*)(ws + WS_XN); (void)XN;
            pg8::Gemm g{(const bf16*)(ws + WS_YS), (const bf16*)(ws + WS_WGLU), M, BW, BW}; pg8::StaticOrder S; S.init(M, BW, G, bx);
            EpiGlu E{(const bf16*)(ws + WS_YS), (bf16*)(ws + WS_Y), INP(a, I_BGLU) + (size_t)l * BW};
            GEMMCALL_GLU<EpiGlu, pg8::StaticOrder, true, true>(lds, g, S, E);
        }
        GRIDSYNC();
        {
            unsigned char* ws = WSP(a); bf16* XN = (bf16*)(ws + WS_XN); (void)XN;
            pg8::Gemm g{(const bf16*)(ws + WS_Y), (const bf16*)(ws + WS_WBR), 3 * M, 3 * D, BW}; OrderG2 S; S.base.init(M, D, G, bx);
            EpiG2 E{(const bf16*)(ws + WS_G), (float*)(ws + WS_Z + 32 * MiB), (bf16*)(ws + WS_Z)};
            GEMMCALL_G2<EpiG2, OrderG2, true, true>(lds, g, S, E);
        }
        GRIDSYNC();
        {
            unsigned char* ws = WSP(a); bf16* XN = (bf16*)(ws + WS_XN); (void)XN;
            pg8::Gemm g{(const bf16*)(ws + WS_Z), (const bf16*)(ws + WS_WOUT), M, D, D}; pg8::StaticOrder S; S.init(M, D, G, bx);
            EpiRes E{a.out};
            GEMMCALL_G3<EpiRes, pg8::StaticOrder, true, true>(lds, g, S, E);
        }
        GRIDSYNC();
        ln_phase(a.out, a.out, (bf16*)(WSP(a) + WS_XN), INP(a, I_LN1G) + (size_t)l * D, INP(a, I_LN1B) + (size_t)l * D, gw, NGW, lane);
        GRIDSYNC();
        {
            unsigned char* ws = WSP(a); bf16* XN = (bf16*)(ws + WS_XN); (void)XN;
            pg8::Gemm g{XN, (const bf16*)(ws + WS_WGU), M, 2 * FF, D}; pg8::StaticOrder S; S.init(M, 2 * FF, G, bx);
            EpiSwiGlu E{(bf16*)(ws + WS_Z)};
            GEMMCALL_G4<EpiSwiGlu, pg8::StaticOrder, true, true>(lds, g, S, E);
        }
        GRIDSYNC();
        {
            unsigned char* ws = WSP(a); bf16* XN = (bf16*)(ws + WS_XN); (void)XN;
            pg8::Gemm g{(const bf16*)(ws + WS_Z), (const bf16*)(ws + WS_WD), M, D, FF}; pg8::StaticOrder S; S.init(M, D, G, bx);
            EpiRes E{a.out};
            GEMMCALL_G5<EpiRes, pg8::StaticOrder, true, true>(lds, g, S, E);
        }
        GRIDSYNC();
        ln_phase(a.out, a.out, (bf16*)(WSP(a) + WS_XN), INP(a, I_LN2G) + (size_t)l * D, INP(a, I_LN2B) + (size_t)l * D, gw, NGW, lane);
#ifndef NO_CONV
        if (l + 1 < DEPTH) convert_phase(a, l + 1, lds, gw, NGW, wave, lane);
#endif
        GRIDSYNC();
    }
}

extern "C" void kernel_launch(void* const* d_in, const int* in_sizes, int n_in, void* d_out, int out_size, void* d_ws, size_t ws_size, hipStream_t stream) {
    static int grid = 0;
    if (grid == 0) {
        if (n_in != 30 || out_size != M * D || ws_size < WS_END) { fprintf(stderr, "kernel_launch: unexpected shapes (n_in %d out %d ws %zu)\n", n_in, out_size, ws_size); grid = -1; return; }
        int dev = 0, cus = 0, per_cu = 0;
        (void)hipGetDevice(&dev); (void)hipDeviceGetAttribute(&cus, hipDeviceAttributeMultiprocessorCount, dev);
        (void)hipFuncSetAttribute((const void*)fwd_kernel, hipFuncAttributeMaxDynamicSharedMemorySize, LDS_BYTES);
        if (hipOccupancyMaxActiveBlocksPerMultiprocessor(&per_cu, (const void*)fwd_kernel, NWAVES * 64, LDS_BYTES) != hipSuccess || per_cu < 1) { fprintf(stderr, "kernel_launch: occupancy query says %d\n", per_cu); per_cu = 1; }
        (void)hipGetLastError();
        grid = cus;
    }
    if (grid < 0) return;
    Args a{};
    for (int i = 0; i < 30; ++i) a.in[i] = (const float*)d_in[i];
    a.out = (float*)d_out; a.ws = (unsigned char*)d_ws;
    void* args[] = {&a};
    hipError_t e = hipLaunchCooperativeKernel((const void*)fwd_kernel, dim3(grid), dim3(NWAVES * 64), args, LDS_BYTES, stream);
    if (e != hipSuccess) fprintf(stderr, "kernel_launch: cooperative launch failed: %s (grid %d)\n", hipGetErrorString(e), grid);
}
```

```cpp
#include <hip/hip_runtime.h>
#include <hip/hip_cooperative_groups.h>
#include <cstdio>
#include <cstdint>
namespace cg = cooperative_groups;
namespace pg8 {
#define PG8_LAS __attribute__((address_space(3)))
typedef unsigned short bf16_t;
typedef short bf16x8 __attribute__((ext_vector_type(8)));
typedef float f32x4 __attribute__((ext_vector_type(4)));
typedef unsigned u32x4 __attribute__((ext_vector_type(4)));
constexpr int BM = 256, BK = 64, HALF = 128, HTB = HALF * BK * 2  , STAGE_BYTES = 8 * HTB, NXCD = 8, WGM = 8;

__host__ __device__ __forceinline__ int lds_byte(int r, int c) { const int st = (r >> 4) * 2 + (c >> 5), rr = r & 15, cc = c & 31, ob = rr * 64 + cc * 2; return st * 1024 + (ob ^ (((ob >> 9) & 1) << 5)); }
__host__ __device__ __forceinline__ void stage_rc(int b, int& R, int& C) { const int st = b / 1024, sb = b % 1024, swz = sb ^ (((sb >> 9) & 1) << 5); R = (st >> 1) * 16 + swz / 64; C = (st & 1) * 32 + (swz % 64) / 2; }
__host__ __device__ __forceinline__ int perm32(int rho) { const int n = rho >> 4, i = rho & 15; return 8 * (i >> 2) + 4 * n + (i & 3); }

struct Unit { int pm, pn; };
struct Gemm { const bf16_t* A; const bf16_t* Bt; int M, N, K; };

struct StaticOrder {
    int nM, nN, nwg, G, c;
    __host__ __device__ void init(int M, int N, int G_, int c_) { nM = M / BM; nN = N / BM; nwg = nM * nN; G = G_; c = c_; }
    __host__ __device__ bool next(int i, Unit& u) const {
        const long L = (long)i * G + c; if (L >= nwg) return false;
        int wgid = (int)L; { const int q = nwg / NXCD, r = nwg % NXCD, xcd = wgid % NXCD, off = wgid / NXCD; wgid = (xcd < r ? xcd * (q + 1) : r * (q + 1) + (xcd - r) * q) + off; }
        const int nig = WGM * nN, gid = wgid / nig, fm = gid * WGM, gsz = (nM - fm) < WGM ? (nM - fm) : WGM;
        u.pm = fm + ((wgid % nig) % gsz); u.pn = (wgid % nig) / gsz; return true;
    }
    __device__ __forceinline__ void a_ready(const Unit&) const {}
    __device__ __forceinline__ void done(const Unit&) const {}
};

__device__ __forceinline__ unsigned cvt_pk_bf16(float lo, float hi) { unsigned r; asm volatile("v_cvt_pk_bf16_f32 %0, %1, %2" : "=v"(r) : "v"(lo), "v"(hi)); return r; }
template <class Epi, class Sched, bool ALIGN_EPI = false, bool SP2 = false>
__device__ __forceinline__ void gemm_phase(PG8_LAS unsigned char* lds, const Gemm g, const Sched& S, const Epi& E) {
    int tid_raw_ = threadIdx.x; asm volatile("" : "+v"(tid_raw_));
    const int tid = tid_raw_, wid = __builtin_amdgcn_readfirstlane(tid >> 6), lane = tid & 63, wr = wid >> 2, wc = wid & 3, fr = lane & 15, fq = lane >> 4;
    const int K = g.K, nt = K / BK;
    unsigned voffA[2], voffB[2];
#pragma unroll
    for (int i = 0; i < 2; ++i) { int R, C; stage_rc(tid * 16 + i * 8192, R, C); const int Rb = Epi::PERM ? ((R & ~31) + perm32(R & 31)) : R;
        voffA[i] = (unsigned)(R * K + C) * 2u; voffB[i] = (unsigned)(Rb * K + C) * 2u; }
    const size_t kstep = (size_t)(BK * 2);
    const size_t hstep = (size_t)HALF * K * 2;
    const size_t tstep = 2 * hstep;
    const unsigned ldsw = (unsigned)wid * 1024u;
    const int aoff = lds_byte(wr * 64 + fr, fq * 8), boff = lds_byte(wc * 32 + fr, fq * 8);
#define PG8_SA(b, h) (((b) * 2 + (h)) * HTB)
#define PG8_SB(b, h) ((4 + (b) * 2 + (h)) * HTB)
#define PG8_STAGE(bufoff, gbase, voff) do { _Pragma("unroll") for (int _i = 0; _i < 2; ++_i) \
        __builtin_amdgcn_global_load_lds((const unsigned*)((const char*)(gbase) + (voff)[_i]), (PG8_LAS unsigned*)(lds + (bufoff) + ldsw + _i * 8192), 16, 0, 0); } while (0)
#define PG8_LDA(dst, b, h) do { _Pragma("unroll") for (int m = 0; m < 4; ++m) _Pragma("unroll") for (int k = 0; k < 2; ++k) dst[m][k] = *(const PG8_LAS bf16x8*)(lds + PG8_SA(b, h) + aoff + m * 2048 + k * 1024); } while (0)
#define PG8_LDB(dst, b, h) do { _Pragma("unroll") for (int n = 0; n < 2; ++n) _Pragma("unroll") for (int k = 0; k < 2; ++k) dst[n][k] = *(const PG8_LAS bf16x8*)(lds + PG8_SB(b, h) + boff + n * 2048 + k * 1024); } while (0)
#define PG8_MMA(ai, bj, At, Bt) do { __builtin_amdgcn_s_setprio(1); _Pragma("unroll") for (int m = 0; m < 4; ++m) _Pragma("unroll") for (int n = 0; n < 2; ++n) _Pragma("unroll") for (int k = 0; k < 2; ++k) \
        acc[ai][bj][m][n] = __builtin_amdgcn_mfma_f32_16x16x32_bf16(Bt[n][k], At[m][k], acc[ai][bj][m][n], 0, 0, 0); __builtin_amdgcn_s_setprio(0); } while (0)
#define PG8_WAIT_V(n) asm volatile("s_waitcnt vmcnt(" #n ")" ::: "memory")
#define PG8_WAIT_L(n) asm volatile("s_waitcnt lgkmcnt(" #n ")" ::: "memory")
#define PG8_BAR __builtin_amdgcn_s_barrier()
#define PG8_SCHED __builtin_amdgcn_sched_barrier(0)
    Unit cur, nxt; int ui = 0;
    if (!S.next(0, cur)) return;
    f32x4 acc[2][2][4][2];
#pragma unroll
    for (int a = 0; a < 2; ++a)
#pragma unroll
        for (int b = 0; b < 2; ++b)
#pragma unroll
            for (int m = 0; m < 4; ++m)
#pragma unroll
                for (int n = 0; n < 2; ++n) acc[a][b][m][n] = (f32x4){0.f, 0.f, 0.f, 0.f};
    bf16x8 At[4][2], B0[2][2], B1[2][2];
    const char* cA = (const char*)g.A + (size_t)cur.pm * tstep; const char* cB = (const char*)g.Bt + (size_t)cur.pn * tstep;
    S.a_ready(cur);
    if constexpr (SP2) {
        PG8_STAGE(PG8_SB(0, 0), cB, voffB); PG8_STAGE(PG8_SB(0, 1), cB + hstep, voffB); PG8_STAGE(PG8_SA(0, 0), cA, voffA); PG8_STAGE(PG8_SA(0, 1), cA + hstep, voffA);
        if (wr == 1) PG8_BAR;
        PG8_WAIT_V(2); PG8_BAR;
        PG8_STAGE(PG8_SB(1, 0), cB + kstep, voffB); PG8_STAGE(PG8_SA(1, 0), cA + kstep, voffA); PG8_STAGE(PG8_SB(1, 1), cB + hstep + kstep, voffB);
        PG8_WAIT_V(6); PG8_BAR;
    } else {
        PG8_STAGE(PG8_SB(0, 0), cB, voffB); PG8_STAGE(PG8_SA(0, 0), cA, voffA); PG8_STAGE(PG8_SB(0, 1), cB + hstep, voffB); PG8_STAGE(PG8_SA(0, 1), cA + hstep, voffA);
        if (wr == 1) PG8_BAR;
        PG8_WAIT_V(4); PG8_BAR;
        PG8_STAGE(PG8_SB(1, 0), cB + kstep, voffB); PG8_STAGE(PG8_SA(1, 0), cA + kstep, voffA); PG8_STAGE(PG8_SB(1, 1), cB + hstep + kstep, voffB);
        PG8_WAIT_V(6); PG8_BAR;
    }
    for (;;) {
        const bool has_next = S.next(ui + 1, nxt);
        const char* nA = has_next ? (const char*)g.A + (size_t)nxt.pm * tstep : cA; const char* nB = has_next ? (const char*)g.Bt + (size_t)nxt.pn * tstep : cB;
        for (int t = 0; t < nt; t += 2) {
            const bool last = (t == nt - 2);
            const char* a1 = cA + (size_t)(t + 1) * kstep;
            const char* a2 = last ? nA : cA + (size_t)(t + 2) * kstep; const char* b2 = last ? nB : cB + (size_t)(t + 2) * kstep;
            const char* a3 = a2 + kstep; const char* b3 = b2 + kstep;
            if (last && has_next) S.a_ready(nxt);
            if constexpr (SP2) {
            PG8_LDB(B0, 0, 0); PG8_LDB(B1, 0, 1); PG8_SCHED; PG8_LDA(At, 0, 0); PG8_STAGE(PG8_SA(1, 1), a1 + hstep, voffA);
            PG8_WAIT_V(8); PG8_WAIT_L(0); PG8_BAR; PG8_MMA(0, 0, At, B0); PG8_MMA(0, 1, At, B1); PG8_BAR; PG8_SCHED;
            PG8_LDA(At, 0, 1); PG8_STAGE(PG8_SB(0, 0), b2, voffB); PG8_STAGE(PG8_SB(0, 1), b2 + hstep, voffB); PG8_STAGE(PG8_SA(0, 0), a2, voffA);
            PG8_WAIT_V(8); PG8_WAIT_L(0); PG8_BAR; PG8_MMA(1, 0, At, B0); PG8_MMA(1, 1, At, B1); PG8_BAR; PG8_SCHED;
            PG8_LDB(B0, 1, 0); PG8_LDB(B1, 1, 1); PG8_SCHED; PG8_LDA(At, 1, 0); PG8_STAGE(PG8_SA(0, 1), a2 + hstep, voffA);
            PG8_WAIT_V(8); PG8_WAIT_L(0); PG8_BAR; PG8_MMA(0, 0, At, B0); PG8_MMA(0, 1, At, B1); PG8_BAR; PG8_SCHED;
            PG8_LDA(At, 1, 1); PG8_STAGE(PG8_SB(1, 0), b3, voffB); PG8_STAGE(PG8_SB(1, 1), b3 + hstep, voffB); PG8_STAGE(PG8_SA(1, 0), a3, voffA);
            PG8_WAIT_V(8); PG8_WAIT_L(0); PG8_BAR; PG8_MMA(1, 0, At, B0); PG8_MMA(1, 1, At, B1); PG8_BAR; PG8_SCHED;
            } else {
            PG8_LDB(B0, 0, 0); PG8_SCHED; PG8_LDA(At, 0, 0); PG8_STAGE(PG8_SA(1, 1), a1 + hstep, voffA);
            PG8_WAIT_L(8); PG8_BAR; PG8_WAIT_L(0); PG8_MMA(0, 0, At, B0); PG8_BAR; PG8_SCHED;
            PG8_LDB(B1, 0, 1); PG8_STAGE(PG8_SB(0, 0), b2, voffB);
            PG8_BAR; PG8_WAIT_L(0); PG8_MMA(0, 1, At, B1); PG8_BAR;
            PG8_LDA(At, 0, 1); PG8_STAGE(PG8_SA(0, 0), a2, voffA);
            PG8_BAR; PG8_WAIT_L(0); PG8_MMA(1, 0, At, B0); PG8_BAR; PG8_SCHED;
            PG8_STAGE(PG8_SB(0, 1), b2 + hstep, voffB);
            PG8_WAIT_V(6); PG8_BAR; PG8_MMA(1, 1, At, B1); PG8_BAR;
            PG8_LDB(B0, 1, 0); PG8_SCHED; PG8_LDA(At, 1, 0); PG8_STAGE(PG8_SA(0, 1), a2 + hstep, voffA);
            PG8_WAIT_L(8); PG8_BAR; PG8_WAIT_L(0); PG8_MMA(0, 0, At, B0); PG8_BAR; PG8_SCHED;
            PG8_LDB(B1, 1, 1); PG8_STAGE(PG8_SB(1, 0), b3, voffB);
            PG8_BAR; PG8_WAIT_L(0); PG8_MMA(0, 1, At, B1); PG8_BAR;
            PG8_LDA(At, 1, 1); PG8_STAGE(PG8_SA(1, 0), a3, voffA);
            PG8_BAR; PG8_WAIT_L(0); PG8_MMA(1, 0, At, B0); PG8_BAR; PG8_SCHED;
            PG8_STAGE(PG8_SB(1, 1), b3 + hstep, voffB);
            PG8_WAIT_V(6); PG8_BAR; PG8_MMA(1, 1, At, B1); PG8_BAR;
            }
        }
        if constexpr (ALIGN_EPI) { if (wr == 0) PG8_BAR; }
        if constexpr (!Epi::AFTER_DRAIN) { E(acc, cur, wr, wc, fr, fq); S.done(cur); }
        if (!has_next) break;
#pragma unroll
        for (int a = 0; a < 2; ++a)
#pragma unroll
            for (int b = 0; b < 2; ++b)
#pragma unroll
                for (int m = 0; m < 4; ++m)
#pragma unroll
                    for (int n = 0; n < 2; ++n) acc[a][b][m][n] = (f32x4){0.f, 0.f, 0.f, 0.f};
        cur = nxt; cA = nA; cB = nB; ++ui;
        if constexpr (ALIGN_EPI) { if (wr == 1) PG8_BAR; }
    }
    PG8_WAIT_V(0);
    if constexpr (!ALIGN_EPI) { if (wr == 0) PG8_BAR; }
    PG8_BAR;
    if constexpr (Epi::AFTER_DRAIN) { E.fused(acc, cur, wr, wc, fr, fq, lds, wid, lane); S.done(cur); }
#undef PG8_SA
#undef PG8_SB
#undef PG8_STAGE
#undef PG8_LDA
#undef PG8_LDB
#undef PG8_MMA
#undef PG8_WAIT_V
#undef PG8_WAIT_L
#undef PG8_BAR
#undef PG8_SCHED
}
}

constexpr int NB = 4, SEQ = 4096, D = 1024, M = NB * SEQ, BW = 512, FF = 2816, NIN = 6144, NINF = 6152, DEPTH = 4, NWAVES = 8;
constexpr int NCH = SEQ / 64;
constexpr float ALPHA = 1.6817928305074292f, LN_EPS = 1e-5f, LOG2E = 1.4426950408889634f;
constexpr float QSCALE = 0.125f * LOG2E;
constexpr size_t MiB = 1u << 20;
constexpr size_t WS_WIN = 1 * MiB, WS_WBR = 13 * MiB, WS_WOUT = 16 * MiB, WS_WGU = 18 * MiB, WS_WD = 29 * MiB, WS_WGLU = 35 * MiB, WS_WFG = 35 * MiB + 512 * 1024;
constexpr size_t WS_KERN = 36 * MiB, WS_WB = 37 * MiB, WS_WDD = 45 * MiB, WS_LAMC = 53 * MiB, WS_WAX = 53 * MiB + 256 * 1024;
constexpr size_t WS_XN = 54 * MiB;
constexpr size_t WS_Z = 86 * MiB;
constexpr size_t WS_G = 182 * MiB;
constexpr size_t WS_Y = 278 * MiB;
constexpr size_t WS_YS = 326 * MiB;
constexpr size_t WS_YI = 342 * MiB;
constexpr size_t WS_S = 374 * MiB;
constexpr size_t WS_LOGF = 378 * MiB;
constexpr size_t WS_AE = 379 * MiB, WS_HE = 379 * MiB + 512 * 1024;
constexpr size_t WS_END = 380 * MiB;
constexpr int LDS_BYTES = 147456;

#define LAS __attribute__((address_space(3)))
typedef unsigned short bf16;
typedef unsigned v4u __attribute__((ext_vector_type(4)));
typedef unsigned v2u __attribute__((ext_vector_type(2)));
typedef float f32x4 __attribute__((ext_vector_type(4)));
typedef float f32x16 __attribute__((ext_vector_type(16)));
typedef short bf16x8 __attribute__((ext_vector_type(8)));
typedef short s16x4 __attribute__((ext_vector_type(4)));
#define LDS_WAIT() asm volatile("s_waitcnt lgkmcnt(0)" ::: "memory")

__device__ __forceinline__ unsigned f2bf(float f) { unsigned u = __builtin_bit_cast(unsigned, f); return (u + 0x7fffu + ((u >> 16) & 1u)) >> 16; }
__device__ __forceinline__ unsigned pk2(float lo, float hi) { return f2bf(lo) | (f2bf(hi) << 16); }
__device__ __forceinline__ float bf2f(unsigned short b) { return __builtin_bit_cast(float, (unsigned)b << 16); }
__device__ __forceinline__ float bflo(unsigned w) { return __builtin_bit_cast(float, w << 16); }
__device__ __forceinline__ float bfhi(unsigned w) { return __builtin_bit_cast(float, w & 0xffff0000u); }
__device__ __forceinline__ float sigmoidf_(float x) { return __builtin_amdgcn_rcpf(1.f + __expf(-x)); }
__device__ __forceinline__ float gelu_tanh(float x) { const float u = 0.7978845608028654f * (x + 0.044715f * x * x * x); const float t = 1.f - 2.f * __builtin_amdgcn_rcpf(__expf(2.f * u) + 1.f); return 0.5f * x * (1.f + t); }
__device__ __forceinline__ float wave_sum(float v) {
#pragma unroll
    for (int o = 1; o < 64; o <<= 1) v += __shfl_xor(v, o);
    return v;
}
__device__ __forceinline__ int crow(int r, int hi) { return (r & 3) + 8 * (r >> 2) + 4 * hi; }

struct EpiG1 {
    static constexpr bool PERM = true, AFTER_DRAIN = false;
    bf16* Z; bf16* Gt; const float* bgate;
    __device__ __forceinline__ void operator()(const f32x4 (&acc)[2][2][4][2], const pg8::Unit& u, int wr, int wc, int fr, int fq) const {
        const int row0 = u.pm * 256 + wr * 64 + fr, pn = u.pn;
#pragma unroll
        for (int ai = 0; ai < 2; ++ai)
#pragma unroll
            for (int m = 0; m < 4; ++m) {
                const int row = row0 + ai * 128 + m * 16;
#pragma unroll
                for (int bj = 0; bj < 2; ++bj) {
                    f32x4 v0 = acc[ai][bj][m][0], v1 = acc[ai][bj][m][1];
                    const int ct = bj * 128 + wc * 32 + 8 * fq;
                    bf16* dst;
                    if (pn < 2) { const int col = pn * 256 + ct; dst = Z + ((size_t)(col >> 4) * M + row) * 16 + (col & 15); }
                    else if (pn < 12) { const int t = (pn - 2) >> 1; const int col = (pn & 1) * 256 + ct; dst = Z + (size_t)(1 + t) * M * 512 + (size_t)row * 512 + col; if (t == 2) { v0 = v0 * QSCALE; v1 = v1 * QSCALE; } }
                    else { const int col = (pn - 12) * 256 + ct; dst = Gt + (size_t)row * 3072 + col; const f32x4 b0 = *(const f32x4*)(bgate + col), b1 = *(const f32x4*)(bgate + col + 4);
#pragma unroll
                        for (int j = 0; j < 4; ++j) { v0[j] = sigmoidf_(v0[j] + b0[j]); v1[j] = sigmoidf_(v1[j] + b1[j]); } }
                    v4u w; w.x = pk2(v0[0], v0[1]); w.y = pk2(v0[2], v0[3]); w.z = pk2(v1[0], v1[1]); w.w = pk2(v1[2], v1[3]);
                    *(v4u*)dst = w;
                }
                asm volatile("" ::: "memory");
            }
    }
};
struct OrderG2 {
    pg8::StaticOrder base;
    __device__ __forceinline__ bool next(int i, pg8::Unit& u) const { const int r = i / 3, k = i - 3 * r; pg8::Unit t; if (!base.next(r, t)) return false; u.pm = k * 64 + t.pm; u.pn = k * 4 + t.pn; return true; }
    __device__ __forceinline__ void a_ready(const pg8::Unit&) const {}
    __device__ __forceinline__ void done(const pg8::Unit&) const {}
};
struct EpiG2 {
    static constexpr bool PERM = true, AFTER_DRAIN = false;
    const bf16* Gt; float* GSF; bf16* GS;
    __device__ __forceinline__ void operator()(const f32x4 (&acc)[2][2][4][2], const pg8::Unit& u, int wr, int wc, int fr, int fq) const {
        const int k = u.pm >> 6, pm = u.pm & 63, pn = u.pn & 3;
        const int row0 = pm * 256 + wr * 64 + fr;
#pragma unroll
        for (int ai = 0; ai < 2; ++ai)
#pragma unroll
            for (int m = 0; m < 4; ++m) {
                const int row = row0 + ai * 128 + m * 16;
#pragma unroll
                for (int bj = 0; bj < 2; ++bj) {
                    const int col = pn * 256 + bj * 128 + wc * 32 + 8 * fq;
                    const v4u gw = *(const v4u*)(Gt + (size_t)row * 3072 + k * 1024 + col);
                    f32x4 v0 = acc[ai][bj][m][0], v1 = acc[ai][bj][m][1];
                    v0[0] *= bflo(gw.x); v0[1] *= bfhi(gw.x); v0[2] *= bflo(gw.y); v0[3] *= bfhi(gw.y);
                    v1[0] *= bflo(gw.z); v1[1] *= bfhi(gw.z); v1[2] *= bflo(gw.w); v1[3] *= bfhi(gw.w);
                    float* sp = GSF + (size_t)row * 1024 + col;
                    if (k > 0) { v0 = v0 + *(const f32x4*)sp; v1 = v1 + *(const f32x4*)(sp + 4); }
                    if (k < 2) { *(f32x4*)sp = v0; *(f32x4*)(sp + 4) = v1; }
                    else { v4u w; w.x = pk2(v0[0], v0[1]); w.y = pk2(v0[2], v0[3]); w.z = pk2(v1[0], v1[1]); w.w = pk2(v1[2], v1[3]); *(v4u*)(GS + (size_t)row * 1024 + col) = w; }
                }
                asm volatile("" ::: "memory");
            }
    }
};
struct EpiRes {
    static constexpr bool PERM = false, AFTER_DRAIN = false;
    float* X;
    __device__ __forceinline__ void operator()(const f32x4 (&acc)[2][2][4][2], const pg8::Unit& u, int wr, int wc, int fr, int fq) const {
        const int row0 = u.pm * 256 + wr * 64 + fr, col0 = u.pn * 256 + wc * 32 + 4 * fq;
#pragma unroll
        for (int ai = 0; ai < 2; ++ai)
#pragma unroll
            for (int m = 0; m < 4; ++m) { float* rowp = X + (size_t)(row0 + ai * 128 + m * 16) * 1024 + col0;
#pragma unroll
                for (int bj = 0; bj < 2; ++bj)
#pragma unroll
                    for (int n = 0; n < 2; ++n) { f32x4* p = (f32x4*)(rowp + bj * 128 + n * 16); *p = (*p) * ALPHA + acc[ai][bj][m][n]; }
                asm volatile("" ::: "memory"); }
    }
};
struct EpiSwiGlu {
    static constexpr bool PERM = true, AFTER_DRAIN = false;
    bf16* H;
    __device__ __forceinline__ void operator()(const f32x4 (&acc)[2][2][4][2], const pg8::Unit& u, int wr, int wc, int fr, int fq) const {
        const int row0 = u.pm * 256 + wr * 64 + fr;
#pragma unroll
        for (int ai = 0; ai < 2; ++ai)
#pragma unroll
            for (int m = 0; m < 4; ++m) {
                const int row = row0 + ai * 128 + m * 16;
#pragma unroll
                for (int bj = 0; bj < 2; ++bj) {
                    const f32x4 g = acc[ai][bj][m][0], up = acc[ai][bj][m][1]; float h[4];
#pragma unroll
                    for (int j = 0; j < 4; ++j) h[j] = g[j] * sigmoidf_(g[j]) * up[j];
                    const int col = u.pn * 128 + bj * 64 + wc * 16 + 4 * fq;
                    v2u w; w.x = pk2(h[0], h[1]); w.y = pk2(h[2], h[3]);
                    *(v2u*)(H + (size_t)row * FF + col) = w;
                }
                asm volatile("" ::: "memory");
            }
    }
};
struct EpiGlu {
    static constexpr bool PERM = true, AFTER_DRAIN = false;
    const bf16* YS; bf16* Y0; const float* bglu;
    __device__ __forceinline__ void operator()(const f32x4 (&acc)[2][2][4][2], const pg8::Unit& u, int wr, int wc, int fr, int fq) const {
        const int row0 = u.pm * 256 + wr * 64 + fr;
#pragma unroll
        for (int ai = 0; ai < 2; ++ai)
#pragma unroll
            for (int m = 0; m < 4; ++m) {
                const int row = row0 + ai * 128 + m * 16;
#pragma unroll
                for (int bj = 0; bj < 2; ++bj) {
                    const int col = u.pn * 256 + bj * 128 + wc * 32 + 8 * fq;
                    const v4u yw = *(const v4u*)(YS + (size_t)row * 512 + col);
                    const f32x4 b0 = *(const f32x4*)(bglu + col), b1 = *(const f32x4*)(bglu + col + 4);
                    const f32x4 a0 = acc[ai][bj][m][0], a1 = acc[ai][bj][m][1];
                    float o[8];
                    o[0] = bflo(yw.x) * sigmoidf_(a0[0] + b0[0]); o[1] = bfhi(yw.x) * sigmoidf_(a0[1] + b0[1]); o[2] = bflo(yw.y) * sigmoidf_(a0[2] + b0[2]); o[3] = bfhi(yw.y) * sigmoidf_(a0[3] + b0[3]);
                    o[4] = bflo(yw.z) * sigmoidf_(a1[0] + b1[0]); o[5] = bfhi(yw.z) * sigmoidf_(a1[1] + b1[1]); o[6] = bflo(yw.w) * sigmoidf_(a1[2] + b1[2]); o[7] = bfhi(yw.w) * sigmoidf_(a1[3] + b1[3]);
                    v4u w; w.x = pk2(o[0], o[1]); w.y = pk2(o[2], o[3]); w.z = pk2(o[4], o[5]); w.w = pk2(o[6], o[7]);
                    *(v4u*)(Y0 + (size_t)row * 512 + col) = w;
                }
                asm volatile("" ::: "memory");
            }
    }
};

struct Args { const float* in[30]; float* out; unsigned char* ws; };
enum { I_X = 0, I_WIN, I_BF, I_BGATE, I_ARE, I_AIM, I_LOGDT, I_BRE, I_BIM, I_CRE, I_CIM, I_SD, I_WGLU, I_BGLU, I_CONVW, I_CONVB, I_WA, I_BA, I_WX, I_BX, I_LAM, I_WBR, I_WOUT, I_LN1G, I_LN1B, I_WFG, I_WFU, I_WFD, I_LN2G, I_LN2B };

__device__ __forceinline__ unsigned char* WSP(const Args& a) { unsigned char* p = a.ws; asm volatile("" : "+s"(p)); return p; }
__device__ __forceinline__ const float* INP(const Args& a, int i) { asm volatile("" : "+s"(i)); return a.in[i]; }
__device__ __forceinline__ void tr_item(const float* W, int ldw, int K, int col_off, int nblk, bf16* WT, int mode, int row_off, LAS float* scr, int item, int lane) {
    const int kb = item / nblk, nb = item - kb * nblk, k0 = 64 * kb, n0 = 32 * nb;
#pragma unroll 8
    for (int i = 0; i < 32; ++i) { const int kk = 2 * i + (lane >> 5); scr[kk * 33 + (lane & 31)] = W[(size_t)(k0 + kk) * ldw + col_off + n0 + (lane & 31)]; }
    LDS_WAIT();
    const int c = lane & 7;
#pragma unroll
    for (int j = 0; j < 4; ++j) { const int n = (lane >> 3) + 8 * j; const LAS float* s = scr + (8 * c) * 33 + n;
        v4u o; o.x = pk2(s[0 * 33], s[1 * 33]); o.y = pk2(s[2 * 33], s[3 * 33]); o.z = pk2(s[4 * 33], s[5 * 33]); o.w = pk2(s[6 * 33], s[7 * 33]);
        const int ns = n0 + n; const int orow = (mode == 0) ? (row_off + ns) : (8 * (ns >> 2) + (ns & 3) + (mode == 2 ? 4 : 0));
        *(v4u*)(WT + (size_t)orow * K + k0 + 8 * c) = o; }
    LDS_WAIT();
}
__device__ __forceinline__ void cexp_pow(float are, float aim, float dt, int j, float& re, float& im) {
    const float mag = expf(are * dt * (float)j);
    double ang = (double)aim * (double)dt * (double)j;
    ang -= rint(ang * 0.15915494309189535) * 6.283185307179586;
    const float a = (float)ang;
    re = mag * cosf(a); im = mag * sinf(a);
}
__device__ __forceinline__ void convert_phase(const Args& a, int l, LAS unsigned char* lds, int gw, int NGW, int wave, int lane) {
    asm volatile("" : "+v"(lane)); asm volatile("" : "+s"(wave), "+s"(gw));
    unsigned char* ws = WSP(a);
    LAS float* scr = (LAS float*)(lds + wave * 16384);
    constexpr int I0 = 16 * 96, I1 = I0 + 16 * 96, I2 = I1 + 3 * 8 * 32, I3 = I2 + 16 * 32, I4 = I3 + 16 * 88, I5 = I4 + 16 * 88, I6 = I5 + 44 * 32, I7 = I6 + 8 * 16;
    for (int it = gw; it < I7; it += NGW) {
        if (it < I0) tr_item(INP(a, I_WIN) + (size_t)l * D * NINF, NINF, D, 0, 96, (bf16*)(ws + WS_WIN), 0, 0, scr, it, lane);
        else if (it < I1) tr_item(INP(a, I_WIN) + (size_t)l * D * NINF, NINF, D, 3080, 96, (bf16*)(ws + WS_WIN), 0, 3072, scr, it - I0, lane);
        else if (it < I2) { const int r = it - I1, k = r / 256; tr_item(INP(a, I_WBR) + (size_t)(l * 3 + k) * BW * D, D, BW, 0, 32, (bf16*)(ws + WS_WBR), 0, k * 1024, scr, r - k * 256, lane); }
        else if (it < I3) tr_item(INP(a, I_WOUT) + (size_t)l * D * D, D, D, 0, 32, (bf16*)(ws + WS_WOUT), 0, 0, scr, it - I2, lane);
        else if (it < I4) tr_item(INP(a, I_WFG) + (size_t)l * D * FF, FF, D, 0, 88, (bf16*)(ws + WS_WGU), 1, 0, scr, it - I3, lane);
        else if (it < I5) tr_item(INP(a, I_WFU) + (size_t)l * D * FF, FF, D, 0, 88, (bf16*)(ws + WS_WGU), 2, 0, scr, it - I4, lane);
        else if (it < I6) tr_item(INP(a, I_WFD) + (size_t)l * FF * D, D, FF, 0, 32, (bf16*)(ws + WS_WD), 0, 0, scr, it - I5, lane);
        else tr_item(INP(a, I_WGLU) + (size_t)l * BW * BW, BW, BW, 0, 16, (bf16*)(ws + WS_WGLU), 0, 0, scr, it - I6, lane);
    }
    { float* wfg = (float*)(ws + WS_WFG); const float* win = INP(a, I_WIN) + (size_t)l * D * NINF;
      for (int e = gw * 64 + lane; e < 8 * D; e += NGW * 64) { const int h = e >> 10, k = e & 1023; wfg[e] = win[(size_t)k * NINF + 3072 + h]; } }
    { bf16* wax = (bf16*)(ws + WS_WAX);
      for (int e = gw * 64 + lane; e < 8 * 2 * 64 * 64; e += NGW * 64) { const int h = e >> 13, gt = (e >> 12) & 1, j = (e >> 6) & 63, i = e & 63;
          const float* src = (gt ? INP(a, I_WX) : INP(a, I_WA)) + ((size_t)(l * 8 + h) * 64 + i) * 64 + j; wax[e] = (bf16)f2bf(*src); } }
    {
        bf16* KERN = (bf16*)(ws + WS_KERN); bf16* WB = (bf16*)(ws + WS_WB); bf16* WDD = (bf16*)(ws + WS_WDD); float* LAMC = (float*)(ws + WS_LAMC);
        LAS float* Tre = scr; LAS float* Tim = scr + 1024;
        for (int it = gw; it < 32 * 65; it += NGW) {
            const int g = it / 65, j = it - g * 65, p = lane;
            const float are = INP(a, I_ARE)[(l * 32 + g) * 64 + p], aim = INP(a, I_AIM)[(l * 32 + g) * 64 + p], dt = expf(INP(a, I_LOGDT)[l * 32 + g]);
            float lbr, lbi, er, ei;
            cexp_pow(are, aim, dt, 1, lbr, lbi);
            cexp_pow(are, aim, dt, j, er, ei);
            const float nr = lbr - 1.f, ni = lbi, den = 1.f / (are * are + aim * aim);
            const float cfr = (nr * are + ni * aim) * den, cfi = (ni * are - nr * aim) * den;
            if (j == 64) { LAMC[(g * 64 + p) * 2] = er; LAMC[(g * 64 + p) * 2 + 1] = ei; }
            const float* cre = INP(a, I_CRE) + (size_t)(l * 32 + g) * 16 * 64; const float* cim = INP(a, I_CIM) + (size_t)(l * 32 + g) * 16 * 64;
            if (j >= 1) {
                const int t = j - 1;
#pragma unroll 4
                for (int c = 0; c < 16; ++c) { const float cr = cre[c * 64 + p], ci = cim[c * 64 + p];
                    bf16* d = WDD + ((size_t)g * 1024 + t * 16 + c) * 128 + p;
                    d[0] = (bf16)f2bf(cr * er - ci * ei); d[64] = (bf16)f2bf(-(cr * ei + ci * er)); }
            }
            if (j <= 63) {
                const f32x4* brp = (const f32x4*)(INP(a, I_BRE) + ((size_t)(l * 32 + g) * 64 + p) * 16); const f32x4* bip = (const f32x4*)(INP(a, I_BIM) + ((size_t)(l * 32 + g) * 64 + p) * 16);
                const int s = 63 - j;
                bf16* wbr = WB + ((size_t)g * 128 + p) * 1024 + s * 16; bf16* wbi = WB + ((size_t)g * 128 + 64 + p) * 1024 + s * 16;
#pragma unroll
                for (int q = 0; q < 4; ++q) { const f32x4 br = brp[q], bi = bip[q]; f32x4 tr, ti;
#pragma unroll
                    for (int e = 0; e < 4; ++e) { const float bbr = cfr * br[e] - cfi * bi[e], bbi = cfr * bi[e] + cfi * br[e]; tr[e] = er * bbr - ei * bbi; ti[e] = er * bbi + ei * bbr; }
                    *(LAS f32x4*)(Tre + p * 16 + 4 * q) = tr; *(LAS f32x4*)(Tim + p * 16 + 4 * q) = ti;
                    v2u w; w.x = pk2(tr[0], tr[1]); w.y = pk2(tr[2], tr[3]); *(v2u*)(wbr + 4 * q) = w;
                    w.x = pk2(ti[0], ti[1]); w.y = pk2(ti[2], ti[3]); *(v2u*)(wbi + 4 * q) = w; }
                LDS_WAIT();
                const int c = lane >> 2, cq = lane & 3; f32x4 acc = {0.f, 0.f, 0.f, 0.f};
#pragma unroll 4
                for (int p4 = 0; p4 < 16; ++p4) { const f32x4 cr = *(const f32x4*)(cre + c * 64 + 4 * p4), ci = *(const f32x4*)(cim + c * 64 + 4 * p4);
#pragma unroll
                    for (int e = 0; e < 4; ++e) { const f32x4 tr = *(const LAS f32x4*)(Tre + (4 * p4 + e) * 16 + 4 * cq), ti = *(const LAS f32x4*)(Tim + (4 * p4 + e) * 16 + 4 * cq); acc = acc + tr * cr[e] - ti * ci[e]; } }
                v2u w; w.x = pk2(acc[0], acc[1]); w.y = pk2(acc[2], acc[3]);
                *(v2u*)(KERN + (((size_t)g * 64 + j) * 16 + c) * 16 + 4 * cq) = w;
                LDS_WAIT();
            }
        }
    }
}

__device__ __forceinline__ void ln_phase(const float* src, float* X, bf16* XN, const float* gam, const float* bet, int gw, int NGW, int lane) {
    asm volatile("" : "+v"(lane)); asm volatile("" : "+s"(gw));
    for (int m = gw; m < M; m += NGW) {
        const f32x4* xr = (const f32x4*)(src + (size_t)m * D) + lane;
        f32x4 v[4];
#pragma unroll
        for (int j = 0; j < 4; ++j) v[j] = xr[64 * j];
        if (gam) {
            float s = 0.f;
#pragma unroll
            for (int j = 0; j < 4; ++j) s += (v[j].x + v[j].y) + (v[j].z + v[j].w);
            const float mean = wave_sum(s) * (1.f / D); float s2 = 0.f;
#pragma unroll
            for (int j = 0; j < 4; ++j) { v[j] = v[j] - mean; s2 += (v[j].x * v[j].x + v[j].y * v[j].y) + (v[j].z * v[j].z + v[j].w * v[j].w); }
            const float rstd = 1.f / sqrtf(wave_sum(s2) * (1.f / D) + LN_EPS);
#pragma unroll
            for (int j = 0; j < 4; ++j) { const f32x4 gg = *((const f32x4*)gam + lane + 64 * j), bb = *((const f32x4*)bet + lane + 64 * j); v[j] = v[j] * rstd * gg + bb; }
        }
        f32x4* xo = (f32x4*)(X + (size_t)m * D) + lane; v2u* o8 = (v2u*)(XN + (size_t)m * D) + lane;
#pragma unroll
        for (int j = 0; j < 4; ++j) { xo[64 * j] = v[j]; v2u w; w.x = pk2(v[j].x, v[j].y); w.y = pk2(v[j].z, v[j].w); o8[64 * j] = w; }
    }
}

__device__ __forceinline__ void lru_local_item(const Args& a, int l, int item, LAS unsigned char* wl, int lane) {
    unsigned char* ws = WSP(a);
    const int h = item & 7, n = (item >> 3) & 63, b = item >> 9;
    const int ch = h * 64 + lane, fr = lane & 15, fq = lane >> 4;
    const bf16* XL = (const bf16*)(ws + WS_Z) + (size_t)1 * M * 512;
    bf16* HL = (bf16*)(ws + WS_XN); bf16* PP = HL + (size_t)M * 512;
    const bf16* WAX = (const bf16*)(ws + WS_WAX);
    bf16x8 Bf[2][4][2];
#pragma unroll
    for (int gt = 0; gt < 2; ++gt)
#pragma unroll
        for (int nt = 0; nt < 4; ++nt)
#pragma unroll
            for (int ks = 0; ks < 2; ++ks) Bf[gt][nt][ks] = *(const bf16x8*)(WAX + ((size_t)((h * 2 + gt) * 64 + 16 * nt + fr)) * 64 + 32 * ks + 8 * fq);
    const float* cwp = INP(a, I_CONVW) + (size_t)l * 4 * BW;
    const float cw0 = cwp[ch], cw1 = cwp[BW + ch], cw2 = cwp[2 * BW + ch], cw3 = cwp[3 * BW + ch], cb = INP(a, I_CONVB)[l * BW + ch];
    const float lamv = INP(a, I_LAM)[l * BW + ch];
    const float c8 = -8.f * log1pf(expf(-lamv));
    const float ba = INP(a, I_BA)[l * BW + ch], bx = INP(a, I_BX)[l * BW + ch];
    const size_t tok0 = (size_t)b * SEQ + n * 64;
    float xm3 = 0.f, xm2 = 0.f, xm1 = 0.f;
    if (n > 0) { xm3 = bf2f(XL[(tok0 - 3) * 512 + ch]); xm2 = bf2f(XL[(tok0 - 2) * 512 + ch]); xm1 = bf2f(XL[(tok0 - 1) * 512 + ch]); }
    LAS bf16* XC = (LAS bf16*)(wl + 2048);
    LAS float* RG = (LAS float*)(wl + 4352);
    float hloc = 0.f, P = 1.f;
    for (int mt = 0; mt < 4; ++mt) {
        float xc[16];
#pragma unroll
        for (int i = 0; i < 16; ++i) { const float xv = bf2f(XL[(tok0 + mt * 16 + i) * 512 + ch]); xc[i] = cb + cw0 * xm3 + cw1 * xm2 + cw2 * xm1 + cw3 * xv; xm3 = xm2; xm2 = xm1; xm1 = xv; XC[i * 72 + lane] = (bf16)f2bf(xc[i]); }
        LDS_WAIT();
        const bf16x8 A0 = *(const LAS bf16x8*)(XC + fr * 72 + 8 * fq), A1 = *(const LAS bf16x8*)(XC + fr * 72 + 32 + 8 * fq);
#pragma unroll
        for (int gt = 0; gt < 2; ++gt)
#pragma unroll
            for (int nt = 0; nt < 4; ++nt) { f32x4 acc = {0.f, 0.f, 0.f, 0.f};
                acc = __builtin_amdgcn_mfma_f32_16x16x32_bf16(A0, Bf[gt][nt][0], acc, 0, 0, 0);
                acc = __builtin_amdgcn_mfma_f32_16x16x32_bf16(A1, Bf[gt][nt][1], acc, 0, 0, 0);
#pragma unroll
                for (int e = 0; e < 4; ++e) RG[(gt * 16 + 4 * fq + e) * 64 + 16 * nt + fr] = acc[e]; }
        LDS_WAIT();
#pragma unroll
        for (int i = 0; i < 16; ++i) {
            const float ra = RG[i * 64 + lane] + ba, rx = RG[(16 + i) * 64 + lane] + bx;
            const float r = 1.f / (1.f + expf(-ra)), ig = 1.f / (1.f + expf(-rx));
            const float la = c8 * r, av = expf(la), mult = sqrtf(-expm1f(2.f * la));
            hloc = av * hloc + mult * ig * xc[i]; P *= av;
            const size_t o = (tok0 + mt * 16 + i) * 512 + ch;
            HL[o] = (bf16)f2bf(hloc); PP[o] = (bf16)f2bf(P);
        }
        LDS_WAIT();
    }
    float* AE = (float*)(ws + WS_AE); float* HE = (float*)(ws + WS_HE);
    AE[(size_t)(b * NCH + n) * 512 + ch] = P; HE[(size_t)(b * NCH + n) * 512 + ch] = hloc;
}
__device__ __forceinline__ void s5_intra_item(const Args& a, int item, LAS unsigned char* wl, int lane) {
    unsigned char* ws = WSP(a);
    const int g = item & 31, n = (item >> 5) & 63, b = item >> 11;
    const bf16* U2 = (const bf16*)(ws + WS_Z); const bf16* KERN = (const bf16*)(ws + WS_KERN); float* YI = (float*)(ws + WS_YI);
    LAS bf16* ut = (LAS bf16*)wl;
    const size_t tok0 = (size_t)b * SEQ + n * 64;
    { const v4u* src = (const v4u*)(U2 + ((size_t)g * M + tok0 + lane) * 16); const v4u x0 = src[0], x1 = src[1];
      *(LAS v4u*)(ut + (64 + lane) * 16) = x0; *(LAS v4u*)(ut + (64 + lane) * 16 + 8) = x1; }
    LDS_WAIT();
    const int fr = lane & 15, fq = lane >> 4;
    f32x4 acc[4];
#pragma unroll
    for (int mt = 0; mt < 4; ++mt) {
        acc[mt] = (f32x4){0.f, 0.f, 0.f, 0.f};
#pragma unroll 2
        for (int slab = 0; slab < 8 * (mt + 1); ++slab) {
            const int j = 2 * slab + (fq >> 1);
            const bf16x8 A = *(const LAS bf16x8*)(ut + (64 + 16 * mt + fr - j) * 16 + 8 * (fq & 1));
            const bf16x8 B = *(const bf16x8*)(KERN + (((size_t)g * 64 + j) * 16 + fr) * 16 + 8 * (fq & 1));
            acc[mt] = __builtin_amdgcn_mfma_f32_16x16x32_bf16(A, B, acc[mt], 0, 0, 0);
        }
    }
#pragma unroll
    for (int mt = 0; mt < 4; ++mt)
#pragma unroll
        for (int i = 0; i < 4; ++i) YI[(tok0 + 16 * mt + 4 * fq + i) * 512 + g * 16 + fr] = acc[mt][i];
    LDS_WAIT();
}
__device__ __forceinline__ void s5_state_item(const Args& a, int item, int lane) {
    unsigned char* ws = WSP(a);
    const int rt = item & 15, g = item >> 4, b = rt >> 2, n0 = 16 * (rt & 3);
    const bf16* U2 = (const bf16*)(ws + WS_Z); const bf16* WB = (const bf16*)(ws + WS_WB); float* S = (float*)(ws + WS_S);
    const int fr = lane & 15, fq = lane >> 4;
    f32x4 acc[8];
#pragma unroll
    for (int nt = 0; nt < 8; ++nt) acc[nt] = (f32x4){0.f, 0.f, 0.f, 0.f};
#pragma unroll 2
    for (int slab = 0; slab < 32; ++slab) {
        const int s = 2 * slab + (fq >> 1);
        const size_t tok = (size_t)b * SEQ + (n0 + fr) * 64 + s;
        const bf16x8 A = *(const bf16x8*)(U2 + ((size_t)g * M + tok) * 16 + 8 * (fq & 1));
#pragma unroll
        for (int nt = 0; nt < 8; ++nt) { const bf16x8 B = *(const bf16x8*)(WB + ((size_t)g * 128 + 16 * nt + fr) * 1024 + 32 * slab + 8 * fq); acc[nt] = __builtin_amdgcn_mfma_f32_16x16x32_bf16(A, B, acc[nt], 0, 0, 0); }
    }
#pragma unroll
    for (int nt = 0; nt < 8; ++nt)
#pragma unroll
        for (int i = 0; i < 4; ++i) S[((size_t)(b * NCH + n0 + 4 * fq + i) * 32 + g) * 128 + 16 * nt + fr] = acc[nt][i];
}
__device__ __forceinline__ void fg_row(const Args& a, int l, int m, LAS unsigned char* lds, int lane) {
    const f32x4* xr = (const f32x4*)(a.out + (size_t)m * D) + lane;
    f32x4 v[4];
#pragma unroll
    for (int j = 0; j < 4; ++j) v[j] = xr[64 * j];
    const LAS f32x4* wf = (const LAS f32x4*)lds + lane;
    float mine = 0.f;
#pragma unroll
    for (int h = 0; h < 8; ++h) { float s = 0.f;
#pragma unroll
        for (int j = 0; j < 4; ++j) { const f32x4 w = wf[h * 256 + 64 * j]; s += (v[j].x * w.x + v[j].y * w.y) + (v[j].z * w.z + v[j].w * w.w); }
        s = wave_sum(s); if (lane == h) mine = s; asm volatile("" ::: "memory"); }
    if (lane < 8) { const float z = mine + INP(a, I_BF)[l * 8 + lane]; const float lf = fminf(z, 0.f) - log1pf(expf(-fabsf(z)));
        const int b = m >> 12, t = m & 4095; ((float*)(WSP(a) + WS_LOGF))[(size_t)(b * 8 + lane) * SEQ + t] = lf * LOG2E; }
}
__device__ __forceinline__ void slot_a(const Args& a, int l, LAS unsigned char* lds, int gw, int NGW, int wave, int lane, int tid) {
    asm volatile("" : "+v"(lane), "+v"(tid)); asm volatile("" : "+s"(wave), "+s"(gw));
    LAS unsigned char* wl = lds + 32768 + wave * 12800;
    { const f32x4* src = (const f32x4*)(WSP(a) + WS_WFG); LAS f32x4* dst = (LAS f32x4*)lds; for (int i = tid; i < 2048; i += 512) dst[i] = src[i]; }
    { LAS bf16* ut = (LAS bf16*)wl; const v4u z = {0u, 0u, 0u, 0u}; *(LAS v4u*)(ut + lane * 16) = z; *(LAS v4u*)(ut + lane * 16 + 8) = z; }
    LDS_WAIT(); __syncthreads();
#ifndef NO_LRU
    for (int it = gw; it < NB * NCH * 8; it += NGW) lru_local_item(a, l, it, wl, lane);
#endif
#ifndef NO_S5
    for (int it = gw; it < NB * NCH * 32; it += NGW) s5_intra_item(a, it, wl, lane);
    for (int it = gw; it < 4 * 512; it += NGW) if ((it & 3) == 0) s5_state_item(a, it >> 2, lane);
#endif
#ifndef NO_FG
    for (int m = gw; m < M; m += NGW) fg_row(a, l, m, lds, lane);
#endif
}

__device__ __forceinline__ void s5_carry_item(const Args& a, int l, int item, LAS unsigned char* lds, int wave, int lane) {
    unsigned char* ws = WSP(a);
    const int rt = item & 15, g = item >> 4, b = rt >> 2, n0 = 16 * (rt & 3);
    const bf16* U2 = (const bf16*)(ws + WS_Z); const bf16* WDD = (const bf16*)(ws + WS_WDD); const float* S = (const float*)(ws + WS_S);
    const float* YI = (const float*)(ws + WS_YI); bf16* YS = (bf16*)(ws + WS_YS);
    LAS bf16* Hs = (LAS bf16*)(lds + 65536 + wave * 4096);
    const float lcr = ((const float*)(ws + WS_LAMC))[(g * 64 + lane) * 2], lci = ((const float*)(ws + WS_LAMC))[(g * 64 + lane) * 2 + 1];
    float hr = 0.f, hi_ = 0.f;
    for (int m = 0; m < n0 + 16; ++m) {
        if (m >= n0) { Hs[(m - n0) * 128 + lane] = (bf16)f2bf(hr); Hs[(m - n0) * 128 + 64 + lane] = (bf16)f2bf(hi_); }
        const float* sp = S + ((size_t)(b * NCH + m) * 32 + g) * 128;
        const float sr = sp[lane], si = sp[64 + lane];
        const float nr = lcr * hr - lci * hi_ + sr, ni = lcr * hi_ + lci * hr + si; hr = nr; hi_ = ni;
    }
    LDS_WAIT();
    const int fr = lane & 15, fq = lane >> 4;
    bf16x8 Af[4];
#pragma unroll
    for (int s = 0; s < 4; ++s) Af[s] = *(const LAS bf16x8*)(Hs + fr * 128 + 32 * s + 8 * fq);
    const float dsk = INP(a, I_SD)[l * BW + g * 16 + fr];
#pragma unroll 2
    for (int nt = 0; nt < 64; ++nt) {
        f32x4 acc = {0.f, 0.f, 0.f, 0.f};
#pragma unroll
        for (int s = 0; s < 4; ++s) { const bf16x8 B = *(const bf16x8*)(WDD + ((size_t)g * 1024 + 16 * nt + fr) * 128 + 32 * s + 8 * fq); acc = __builtin_amdgcn_mfma_f32_16x16x32_bf16(Af[s], B, acc, 0, 0, 0); }
#pragma unroll
        for (int i = 0; i < 4; ++i) { const size_t tok = (size_t)b * SEQ + (n0 + 4 * fq + i) * 64 + nt;
            const float uu = bf2f(U2[((size_t)g * M + tok) * 16 + fr]);
            const float y = YI[tok * 512 + g * 16 + fr] + acc[i] + dsk * uu;
            YS[tok * 512 + g * 16 + fr] = (bf16)f2bf(gelu_tanh(y)); }
    }
    LDS_WAIT();
}
__device__ __forceinline__ void lru_apply_item(const Args& a, int item, int lane) {
    unsigned char* ws = WSP(a);
    const int h = item & 7, n = (item >> 3) & 63, b = item >> 9;
    const int ch = h * 64 + lane;
    const bf16* HL = (const bf16*)(ws + WS_XN); const bf16* PP = HL + (size_t)M * 512;
    const bf16* GL = (const bf16*)(ws + WS_Z) + (size_t)2 * M * 512;
    bf16* Y1 = (bf16*)(ws + WS_Y) + (size_t)M * 512;
    const float* AE = (const float*)(ws + WS_AE); const float* HE = (const float*)(ws + WS_HE);
    float hin = 0.f;
    for (int m = 0; m < n; ++m) hin = AE[(size_t)(b * NCH + m) * 512 + ch] * hin + HE[(size_t)(b * NCH + m) * 512 + ch];
    const size_t tok0 = (size_t)b * SEQ + n * 64;
#pragma unroll 8
    for (int t = 0; t < 64; ++t) { const size_t o = (tok0 + t) * 512 + ch;
        const float hv = bf2f(HL[o]) + bf2f(PP[o]) * hin;
        Y1[o] = (bf16)f2bf(gelu_tanh(bf2f(GL[o])) * hv); }
}
__device__ __forceinline__ void attn_pair(const Args& a, int b, int h, int s, LAS unsigned char* lds, int wave, int lane, int tid) {
    unsigned char* ws = WSP(a);
    const bf16* Q = (const bf16*)(ws + WS_Z) + (size_t)3 * M * 512; const bf16* K = Q + (size_t)M * 512; const bf16* V = K + (size_t)M * 512;
    bf16* O = (bf16*)(ws + WS_Y) + (size_t)2 * M * 512;
    LAS float* cum = (LAS float*)lds; LAS bf16* Ks = (LAS bf16*)(lds + 16384); LAS bf16* Vt = (LAS bf16*)(lds + 16384 + 9216); LAS float* wsum = (LAS float*)(lds + 16384 + 18432);
    const int r32 = lane & 31, hi = lane >> 5;
    __syncthreads();
    {
        const float* src = (const float*)(ws + WS_LOGF) + (size_t)(b * 8 + h) * SEQ + tid * 8;
        const f32x4 a0 = *(const f32x4*)src, a1 = *(const f32x4*)(src + 4);
        float v[8] = {a0.x, a0.y, a0.z, a0.w, a1.x, a1.y, a1.z, a1.w};
#pragma unroll
        for (int i = 1; i < 8; ++i) v[i] += v[i - 1];
        float incl = v[7];
#pragma unroll
        for (int o = 1; o < 64; o <<= 1) { const float t = __shfl_up(incl, o); if (lane >= o) incl += t; }
        if (lane == 63) wsum[wave] = incl;
        LDS_WAIT(); __syncthreads();
        float off = incl - v[7];
        for (int w = 0; w < wave; ++w) off += wsum[w];
        f32x4 o0 = {v[0] + off, v[1] + off, v[2] + off, v[3] + off}, o1 = {v[4] + off, v[5] + off, v[6] + off, v[7] + off};
        *(LAS f32x4*)(cum + tid * 8) = o0; *(LAS f32x4*)(cum + tid * 8 + 4) = o1;
    }
    LDS_WAIT(); __syncthreads();
    for (int uu = 0; uu < 2; ++uu) {
        const int qb = uu == 0 ? s : 15 - s, q0 = qb * 256;
        const int qrow = q0 + wave * 32 + r32;
        const size_t qtok = (size_t)b * SEQ + qrow;
        bf16x8 qf[4];
#pragma unroll
        for (int ds = 0; ds < 4; ++ds) qf[ds] = *(const bf16x8*)(Q + qtok * 512 + h * 64 + ds * 16 + hi * 8);
        const float cq = cum[qrow];
        float mrun = -1e30f, lrun = 0.f;
        f32x16 o[2];
#pragma unroll
        for (int r = 0; r < 16; ++r) { o[0][r] = 0.f; o[1][r] = 0.f; }
        const int NT = 4 * (qb + 1);
        for (int j = 0; j < NT; ++j) {
            __syncthreads();
            { const int row = tid >> 3, chk = tid & 7; const size_t tok = (size_t)b * SEQ + 64 * j + row;
              const v4u kk = *(const v4u*)(K + tok * 512 + h * 64 + chk * 8); *(LAS v4u*)(Ks + row * 72 + chk * 8) = kk;
              const v4u vv = *(const v4u*)(V + tok * 512 + h * 64 + chk * 8);
              LAS bf16* vd = Vt + (chk * 8) * 72 + row;
              vd[0] = (bf16)(vv.x & 0xffffu); vd[72] = (bf16)(vv.x >> 16); vd[144] = (bf16)(vv.y & 0xffffu); vd[216] = (bf16)(vv.y >> 16);
              vd[288] = (bf16)(vv.z & 0xffffu); vd[360] = (bf16)(vv.z >> 16); vd[432] = (bf16)(vv.w & 0xffffu); vd[504] = (bf16)(vv.w >> 16); }
            LDS_WAIT(); __syncthreads();
            if (64 * j <= q0 + wave * 32 + 31) {
                f32x16 p0, p1;
#pragma unroll
                for (int r = 0; r < 16; ++r) { p0[r] = 0.f; p1[r] = 0.f; }
#pragma unroll
                for (int ds = 0; ds < 4; ++ds) {
                    const bf16x8 k0 = *(const LAS bf16x8*)(Ks + r32 * 72 + ds * 16 + hi * 8);
                    const bf16x8 k1 = *(const LAS bf16x8*)(Ks + (32 + r32) * 72 + ds * 16 + hi * 8);
                    p0 = __builtin_amdgcn_mfma_f32_32x32x16_bf16(k0, qf[ds], p0, 0, 0, 0);
                    p1 = __builtin_amdgcn_mfma_f32_32x32x16_bf16(k1, qf[ds], p1, 0, 0, 0);
                }
                const bool diag = (64 * j + 63 > q0 + wave * 32);
                float mx = -1e30f;
#pragma unroll
                for (int r4 = 0; r4 < 4; ++r4) {
                    const int kvb = 64 * j + 8 * r4 + 4 * hi;
                    const f32x4 c0 = *(const LAS f32x4*)(cum + kvb), c1 = *(const LAS f32x4*)(cum + kvb + 32);
#pragma unroll
                    for (int e = 0; e < 4; ++e) { const int r = 4 * r4 + e;
                        float s0 = p0[r] + (cq - c0[e]), s1 = p1[r] + (cq - c1[e]);
                        if (diag) { if (kvb + e > qrow) s0 = -1e30f; if (kvb + e + 32 > qrow) s1 = -1e30f; }
                        p0[r] = s0; p1[r] = s1; mx = fmaxf(mx, fmaxf(s0, s1)); }
                }
                mx = fmaxf(mx, __shfl_xor(mx, 32));
                const float mnew = fmaxf(mrun, mx), alpha = __builtin_amdgcn_exp2f(mrun - mnew);
                float psum = 0.f;
#pragma unroll
                for (int r = 0; r < 16; ++r) { p0[r] = __builtin_amdgcn_exp2f(p0[r] - mnew); p1[r] = __builtin_amdgcn_exp2f(p1[r] - mnew); psum += p0[r] + p1[r]; }
                lrun = lrun * alpha + psum; mrun = mnew;
#pragma unroll
                for (int r = 0; r < 16; ++r) { o[0][r] *= alpha; o[1][r] *= alpha; }
                bf16x8 pk[4];
#pragma unroll
                for (int sl = 0; sl < 4; ++sl) {
                    v4u w;
                    if (sl < 2) { const int r0 = 8 * (sl & 1); w.x = pk2(p0[r0], p0[r0 + 1]); w.y = pk2(p0[r0 + 2], p0[r0 + 3]); w.z = pk2(p0[r0 + 4], p0[r0 + 5]); w.w = pk2(p0[r0 + 6], p0[r0 + 7]); }
                    else { const int r0 = 8 * (sl & 1); w.x = pk2(p1[r0], p1[r0 + 1]); w.y = pk2(p1[r0 + 2], p1[r0 + 3]); w.z = pk2(p1[r0 + 4], p1[r0 + 5]); w.w = pk2(p1[r0 + 6], p1[r0 + 7]); }
                    pk[sl] = __builtin_bit_cast(bf16x8, w);
                }
#pragma unroll
                for (int db = 0; db < 2; ++db)
#pragma unroll
                    for (int sl = 0; sl < 4; ++sl) {
                        const LAS bf16* vp = Vt + (32 * db + r32) * 72 + 16 * sl + 4 * hi;
                        const v2u lo = *(const LAS v2u*)vp, hh = *(const LAS v2u*)(vp + 8);
                        v4u w; w.x = lo.x; w.y = lo.y; w.z = hh.x; w.w = hh.y;
                        o[db] = __builtin_amdgcn_mfma_f32_32x32x16_bf16(__builtin_bit_cast(bf16x8, w), pk[sl], o[db], 0, 0, 0);
                    }
            }
        }
        lrun += __shfl_xor(lrun, 32);
        const float inv = 1.f / lrun;
#pragma unroll
        for (int db = 0; db < 2; ++db)
#pragma unroll
            for (int r4 = 0; r4 < 4; ++r4) { const int d = 32 * db + 8 * r4 + 4 * hi;
                v2u w; w.x = pk2(o[db][4 * r4] * inv, o[db][4 * r4 + 1] * inv); w.y = pk2(o[db][4 * r4 + 2] * inv, o[db][4 * r4 + 3] * inv);
                *(v2u*)(O + qtok * 512 + h * 64 + d) = w; }
    }
}
__device__ __forceinline__ void slot_b(const Args& a, int l, LAS unsigned char* lds, int gw, int NGW, int vcu, int G, int wave, int lane, int tid) {
    asm volatile("" : "+v"(lane), "+v"(tid)); asm volatile("" : "+s"(wave), "+s"(gw), "+s"(vcu));
#ifndef NO_B12
    for (int it = gw; it < NB * NCH * 8; it += NGW) lru_apply_item(a, it, lane);
    for (int it = gw; it < 4 * 512; it += NGW) if ((it & 3) == 0) s5_carry_item(a, l, it >> 2, lds, wave, lane);
#endif
#ifndef NO_ATTN
    for (int p = vcu; p < 256; p += G) attn_pair(a, p >> 6, (p >> 3) & 7, p & 7, lds, wave, lane, tid);
#endif
}

template <class Epi, class Sched, bool A_, bool B_> __device__ __forceinline__ void gemm_stub(LAS unsigned char*, const pg8::Gemm, const Sched&, const Epi&) {}
#if defined(NO_GEMM) || defined(NO_G1)
#define GEMMCALL_G1 gemm_stub
#else
#define GEMMCALL_G1 pg8::gemm_phase
#endif
#if defined(NO_GEMM) || defined(NO_GLU)
#define GEMMCALL_GLU gemm_stub
#else
#define GEMMCALL_GLU pg8::gemm_phase
#endif
#if defined(NO_GEMM) || defined(NO_G2)
#define GEMMCALL_G2 gemm_stub
#else
#define GEMMCALL_G2 pg8::gemm_phase
#endif
#if defined(NO_GEMM) || defined(NO_G3)
#define GEMMCALL_G3 gemm_stub
#else
#define GEMMCALL_G3 pg8::gemm_phase
#endif
#if defined(NO_GEMM) || defined(NO_G4)
#define GEMMCALL_G4 gemm_stub
#else
#define GEMMCALL_G4 pg8::gemm_phase
#endif
#if defined(NO_GEMM) || defined(NO_G5)
#define GEMMCALL_G5 gemm_stub
#else
#define GEMMCALL_G5 pg8::gemm_phase
#endif
#define XB_TMO      128
#define XB_XCNT(j)  (256  + 64 * (j))
#define XB_XSUB(j)  (1280 + 64 * (j))
#define XB_XGEN(j)  (2304 + 64 * (j))
#define XB_TOP      3328
#define XB_TOPGEN   3392
#define XCD_BAR_WORDS 3456
#define XB_SPIN_CAP (1u << 18)

__device__ __forceinline__ unsigned xb_ld(unsigned* p)              { return __hip_atomic_load(p, __ATOMIC_RELAXED, __HIP_MEMORY_SCOPE_AGENT); }
__device__ __forceinline__ unsigned xb_add(unsigned* p, unsigned v) { return __hip_atomic_fetch_add(p, v, __ATOMIC_RELAXED, __HIP_MEMORY_SCOPE_AGENT); }
__device__ __forceinline__ unsigned xb_xcc_id() { return (unsigned)__builtin_amdgcn_s_getreg((3 << 11) | 20) & 0xFu; }
#define XB_SPIN(cond, bar) do { unsigned _sp = 0; while (cond) { __builtin_amdgcn_s_sleep(1); \
    if ((++_sp & 255u) == 0u) { if (xb_ld(&(bar)[XB_TMO])) break; if (_sp > XB_SPIN_CAP) { atomicAdd(&(bar)[XB_TMO], 1u); break; } } } } while (0)

struct XcdBarrier {
    unsigned* bar; unsigned x;
    volatile LAS unsigned* st;
};

__device__ __forceinline__ XcdBarrier xcd_barrier_post(unsigned* bar, volatile LAS unsigned* st) {
    XcdBarrier b; b.bar = bar; b.x = xb_xcc_id(); b.st = st;
    if (threadIdx.x == 0) (void)xb_add(&bar[XB_XCNT(b.x)], 1u);
    return b;
}
__device__ __forceinline__ void xcd_barrier_complete(unsigned* bar, unsigned x, unsigned& nloc, unsigned& nx) {
    const unsigned G = gridDim.x * gridDim.y * gridDim.z;
    unsigned sum, cnt, mine, sp = 0u;
    for (;;) {
        sum = 0u; cnt = 0u; mine = 0u;
#pragma unroll
        for (unsigned j = 0; j < 16; ++j) { const unsigned c = xb_ld(&bar[XB_XCNT(j)]); sum += c; cnt += (c > 0u) ? 1u : 0u; mine = (j == x) ? c : mine; }
        if (sum == G) break;
        __builtin_amdgcn_s_sleep(1);
        if ((++sp & 255u) == 0u) { if (xb_ld(&bar[XB_TMO])) break; if (sp > XB_SPIN_CAP) { atomicAdd(&bar[XB_TMO], 1u); break; } }
    }
    nloc = mine > 0u ? mine : 1u; nx = cnt > 0u ? cnt : 1u;
}

__device__ __forceinline__ void xcd_barrier(const XcdBarrier& b) {
    asm volatile("s_waitcnt vmcnt(0)" ::: "memory");
    __syncthreads();
    if (threadIdx.x == 0) {
        unsigned* bar = b.bar;
        __builtin_amdgcn_s_waitcnt(0);
        unsigned nloc = b.st[0], nx = b.st[1];
        if (nloc == 0u) { xcd_barrier_complete(bar, b.x, nloc, nx); b.st[0] = nloc; b.st[1] = nx; }
        const unsigned old = xb_add(&bar[XB_XSUB(b.x)], 1u);
        const unsigned gen = old / nloc;
        if (old + 1u == (gen + 1u) * nloc) {
            __builtin_amdgcn_fence(__ATOMIC_RELEASE, "agent");
            asm volatile("s_waitcnt vmcnt(0)" ::: "memory");
            const unsigned og = xb_add(&bar[XB_TOP], 1u);
            const unsigned tg = og / nx;
            if (og + 1u == (tg + 1u) * nx) xb_add(&bar[XB_TOPGEN], 1u);
            else XB_SPIN(xb_ld(&bar[XB_TOPGEN]) == tg, bar);
            __builtin_amdgcn_fence(__ATOMIC_ACQUIRE, "agent");
            xb_add(&bar[XB_XGEN(b.x)], 1u);
            asm volatile("s_waitcnt vmcnt(0)" ::: "memory");
        } else {
            XB_SPIN(xb_ld(&bar[XB_XGEN(b.x)]) == gen, bar);
            __builtin_amdgcn_fence(__ATOMIC_ACQUIRE, "agent");
            asm volatile("s_waitcnt vmcnt(0)" ::: "memory");
        }
    }
    __syncthreads();
}


#define GRIDSYNC() xcd_barrier(xbar)
__global__ void __launch_bounds__(NWAVES * 64, 2) fwd_kernel(Args a) {
    extern __shared__ __attribute__((aligned(16))) unsigned char lds_raw[];
    cg::grid_group grid = cg::this_grid();
    LAS unsigned char* lds = (LAS unsigned char*)lds_raw;
    const int tid = threadIdx.x, lane = tid & 63, wave = __builtin_amdgcn_readfirstlane(tid >> 6);
    const int G = gridDim.x, bx = blockIdx.x;
    const int vcu = (G % 8 == 0) ? (bx % 8) * (G / 8) + bx / 8 : bx;
    const int gw = bx * NWAVES + wave, NGW = G * NWAVES;
    unsigned char* ws0 = WSP(a);
    bf16* XN0 = (bf16*)(ws0 + WS_XN);

    volatile LAS unsigned* xst = (volatile LAS unsigned*)(lds + LDS_BYTES - 64);
    if (tid < 2) xst[tid] = 0u;
    __syncthreads();
    const XcdBarrier xbar = xcd_barrier_post((unsigned*)a.ws, xst);
    ln_phase(INP(a, I_X), a.out, XN0, nullptr, nullptr, gw, NGW, lane);
#ifndef NO_CONV
    convert_phase(a, 0, lds, gw, NGW, wave, lane);
#endif
    grid.sync();

    for (int l = 0; l < DEPTH; ++l) {
        {
            unsigned char* ws = WSP(a); bf16* XN = (bf16*)(ws + WS_XN); (void)XN;
            pg8::Gemm g{XN, (const bf16*)(ws + WS_WIN), M, NIN, D}; pg8::StaticOrder S; S.init(M, NIN, G, bx);
            EpiG1 E{(bf16*)(ws + WS_Z), (bf16*)(ws + WS_G), INP(a, I_BGATE) + (size_t)l * 3072};
            GEMMCALL_G1<EpiG1, pg8::StaticOrder, true, true>(lds, g, S, E);
        }
        GRIDSYNC();
        slot_a(a, l, lds, gw, NGW, wave, lane, tid);
        GRIDSYNC();
        slot_b(a, l, lds, gw, NGW, vcu, G, wave, lane, tid);
        GRIDSYNC();
        {
            unsigned char* ws = WSP(a); bf16* XN = (bf16*)(ws + WS_XN); (void)XN;
            pg8::Gemm g{(const bf16*)(ws + WS_YS), (const bf16*)(ws + WS_WGLU), M, BW, BW}; pg8::StaticOrder S; S.init(M, BW, G, bx);
            EpiGlu E{(const bf16*)(ws + WS_YS), (bf16*)(ws + WS_Y), INP(a, I_BGLU) + (size_t)l * BW};
            GEMMCALL_GLU<EpiGlu, pg8::StaticOrder, true, true>(lds, g, S, E);
        }
        GRIDSYNC();
        {
            unsigned char* ws = WSP(a); bf16* XN = (bf16*)(ws + WS_XN); (void)XN;
            pg8::Gemm g{(const bf16*)(ws + WS_Y), (const bf16*)(ws + WS_WBR), 3 * M, 3 * D, BW}; OrderG2 S; S.base.init(M, D, G, bx);
            EpiG2 E{(const bf16*)(ws + WS_G), (float*)(ws + WS_Z + 32 * MiB), (bf16*)(ws + WS_Z)};
            GEMMCALL_G2<EpiG2, OrderG2, true, true>(lds, g, S, E);
        }
        GRIDSYNC();
        {
            unsigned char* ws = WSP(a); bf16* XN = (bf16*)(ws + WS_XN); (void)XN;
            pg8::Gemm g{(const bf16*)(ws + WS_Z), (const bf16*)(ws + WS_WOUT), M, D, D}; pg8::StaticOrder S; S.init(M, D, G, bx);
            EpiRes E{a.out};
            GEMMCALL_G3<EpiRes, pg8::StaticOrder, true, true>(lds, g, S, E);
        }
        GRIDSYNC();
        ln_phase(a.out, a.out, (bf16*)(WSP(a) + WS_XN), INP(a, I_LN1G) + (size_t)l * D, INP(a, I_LN1B) + (size_t)l * D, gw, NGW, lane);
        GRIDSYNC();
        {
            unsigned char* ws = WSP(a); bf16* XN = (bf16*)(ws + WS_XN); (void)XN;
            pg8::Gemm g{XN, (const bf16*)(ws + WS_WGU), M, 2 * FF, D}; pg8::StaticOrder S; S.init(M, 2 * FF, G, bx);
            EpiSwiGlu E{(bf16*)(ws + WS_Z)};
            GEMMCALL_G4<EpiSwiGlu, pg8::StaticOrder, true, true>(lds, g, S, E);
        }
        GRIDSYNC();
        {
            unsigned char* ws = WSP(a); bf16* XN = (bf16*)(ws + WS_XN); (void)XN;
            pg8::Gemm g{(const bf16*)(ws + WS_Z), (const bf16*)(ws + WS_WD), M, D, FF}; pg8::StaticOrder S; S.init(M, D, G, bx);
            EpiRes E{a.out};
            GEMMCALL_G5<EpiRes, pg8::StaticOrder, true, true>(lds, g, S, E);
        }
        GRIDSYNC();
        ln_phase(a.out, a.out, (bf16*)(WSP(a) + WS_XN), INP(a, I_LN2G) + (size_t)l * D, INP(a, I_LN2B) + (size_t)l * D, gw, NGW, lane);
#ifndef NO_CONV
        if (l + 1 < DEPTH) convert_phase(a, l + 1, lds, gw, NGW, wave, lane);
#endif
        GRIDSYNC();
    }
}

extern "C" void kernel_launch(void* const* d_in, const int* in_sizes, int n_in, void* d_out, int out_size, void* d_ws, size_t ws_size, hipStream_t stream) {
    static int grid = 0;
    if (grid == 0) {
        if (n_in != 30 || out_size != M * D || ws_size < WS_END) { fprintf(stderr, "kernel_launch: unexpected shapes (n_in %d out %d ws %zu)\n", n_in, out_size, ws_size); grid = -1; return; }
        int dev = 0, cus = 0, per_cu = 0;
        (void)hipGetDevice(&dev); (void)hipDeviceGetAttribute(&cus, hipDeviceAttributeMultiprocessorCount, dev);
        (void)hipFuncSetAttribute((const void*)fwd_kernel, hipFuncAttributeMaxDynamicSharedMemorySize, LDS_BYTES);
        if (hipOccupancyMaxActiveBlocksPerMultiprocessor(&per_cu, (const void*)fwd_kernel, NWAVES * 64, LDS_BYTES) != hipSuccess || per_cu < 1) { fprintf(stderr, "kernel_launch: occupancy query says %d\n", per_cu); per_cu = 1; }
        (void)hipGetLastError();
        grid = cus;
    }
    if (grid < 0) return;
    if (hipMemsetAsync(d_ws, 0, 16384, stream) != hipSuccess) { fprintf(stderr, "kernel_launch: memset failed\n"); return; }
    Args a{};
    for (int i = 0; i < 30; ++i) a.in[i] = (const float*)d_in[i];
    a.out = (float*)d_out; a.ws = (unsigned char*)d_ws;
    void* args[] = {&a};
    hipError_t e = hipLaunchCooperativeKernel((const void*)fwd_kernel, dim3(grid), dim3(NWAVES * 64), args, LDS_BYTES, stream);
    if (e != hipSuccess) fprintf(stderr, "kernel_launch: cooperative launch failed: %s (grid %d)\n", hipGetErrorString(e), grid);
}
```

```cpp
#include <hip/hip_runtime.h>
#include <hip/hip_cooperative_groups.h>
#include <cstdio>
#include <cstdint>
namespace cg = cooperative_groups;
namespace pg8 {
#define PG8_LAS __attribute__((address_space(3)))
typedef unsigned short bf16_t;
typedef short bf16x8 __attribute__((ext_vector_type(8)));
typedef float f32x4 __attribute__((ext_vector_type(4)));
typedef unsigned u32x4 __attribute__((ext_vector_type(4)));
constexpr int BM = 256, BK = 64, HALF = 128, HTB = HALF * BK * 2  , STAGE_BYTES = 8 * HTB, NXCD = 8, WGM = 8;

__host__ __device__ __forceinline__ int lds_byte(int r, int c) { const int st = (r >> 4) * 2 + (c >> 5), rr = r & 15, cc = c & 31, ob = rr * 64 + cc * 2; return st * 1024 + (ob ^ (((ob >> 9) & 1) << 5)); }
__host__ __device__ __forceinline__ void stage_rc(int b, int& R, int& C) { const int st = b / 1024, sb = b % 1024, swz = sb ^ (((sb >> 9) & 1) << 5); R = (st >> 1) * 16 + swz / 64; C = (st & 1) * 32 + (swz % 64) / 2; }
__host__ __device__ __forceinline__ int perm32(int rho) { const int n = rho >> 4, i = rho & 15; return 8 * (i >> 2) + 4 * n + (i & 3); }

struct Unit { int pm, pn; };
struct Gemm { const bf16_t* A; const bf16_t* Bt; int M, N, K; };

struct StaticOrder {
    int nM, nN, nwg, G, c;
    __host__ __device__ void init(int M, int N, int G_, int c_) { nM = M / BM; nN = N / BM; nwg = nM * nN; G = G_; c = c_; }
    __host__ __device__ bool next(int i, Unit& u) const {
        const long L = (long)i * G + c; if (L >= nwg) return false;
        int wgid = (int)L; { const int q = nwg / NXCD, r = nwg % NXCD, xcd = wgid % NXCD, off = wgid / NXCD; wgid = (xcd < r ? xcd * (q + 1) : r * (q + 1) + (xcd - r) * q) + off; }
        const int nig = WGM * nN, gid = wgid / nig, fm = gid * WGM, gsz = (nM - fm) < WGM ? (nM - fm) : WGM;
        u.pm = fm + ((wgid % nig) % gsz); u.pn = (wgid % nig) / gsz; return true;
    }
    __device__ __forceinline__ void a_ready(const Unit&) const {}
    __device__ __forceinline__ void done(const Unit&) const {}
};

__device__ __forceinline__ unsigned cvt_pk_bf16(float lo, float hi) { unsigned r; asm volatile("v_cvt_pk_bf16_f32 %0, %1, %2" : "=v"(r) : "v"(lo), "v"(hi)); return r; }
template <class Epi, class Sched, bool ALIGN_EPI = false, bool SP2 = false>
__device__ __forceinline__ void gemm_phase(PG8_LAS unsigned char* lds, const Gemm g, const Sched& S, const Epi& E) {
    int tid_raw_ = threadIdx.x; asm volatile("" : "+v"(tid_raw_));
    const int tid = tid_raw_, wid = __builtin_amdgcn_readfirstlane(tid >> 6), lane = tid & 63, wr = wid >> 2, wc = wid & 3, fr = lane & 15, fq = lane >> 4;
    const int K = g.K, nt = K / BK;
    unsigned voffA[2], voffB[2];
#pragma unroll
    for (int i = 0; i < 2; ++i) { int R, C; stage_rc(tid * 16 + i * 8192, R, C); const int Rb = Epi::PERM ? ((R & ~31) + perm32(R & 31)) : R;
        voffA[i] = (unsigned)(R * K + C) * 2u; voffB[i] = (unsigned)(Rb * K + C) * 2u; }
    const size_t kstep = (size_t)(BK * 2);
    const size_t hstep = (size_t)HALF * K * 2;
    const size_t tstep = 2 * hstep;
    const unsigned ldsw = (unsigned)wid * 1024u;
    const int aoff = lds_byte(wr * 64 + fr, fq * 8), boff = lds_byte(wc * 32 + fr, fq * 8);
#define PG8_SA(b, h) (((b) * 2 + (h)) * HTB)
#define PG8_SB(b, h) ((4 + (b) * 2 + (h)) * HTB)
#define PG8_STAGE(bufoff, gbase, voff) do { _Pragma("unroll") for (int _i = 0; _i < 2; ++_i) \
        __builtin_amdgcn_global_load_lds((const unsigned*)((const char*)(gbase) + (voff)[_i]), (PG8_LAS unsigned*)(lds + (bufoff) + ldsw + _i * 8192), 16, 0, 0); } while (0)
#define PG8_LDA(dst, b, h) do { _Pragma("unroll") for (int m = 0; m < 4; ++m) _Pragma("unroll") for (int k = 0; k < 2; ++k) dst[m][k] = *(const PG8_LAS bf16x8*)(lds + PG8_SA(b, h) + aoff + m * 2048 + k * 1024); } while (0)
#define PG8_LDB(dst, b, h) do { _Pragma("unroll") for (int n = 0; n < 2; ++n) _Pragma("unroll") for (int k = 0; k < 2; ++k) dst[n][k] = *(const PG8_LAS bf16x8*)(lds + PG8_SB(b, h) + boff + n * 2048 + k * 1024); } while (0)
#define PG8_MMA(ai, bj, At, Bt) do { __builtin_amdgcn_s_setprio(1); _Pragma("unroll") for (int m = 0; m < 4; ++m) _Pragma("unroll") for (int n = 0; n < 2; ++n) _Pragma("unroll") for (int k = 0; k < 2; ++k) \
        acc[ai][bj][m][n] = __builtin_amdgcn_mfma_f32_16x16x32_bf16(Bt[n][k], At[m][k], acc[ai][bj][m][n], 0, 0, 0); __builtin_amdgcn_s_setprio(0); } while (0)
#define PG8_WAIT_V(n) asm volatile("s_waitcnt vmcnt(" #n ")" ::: "memory")
#define PG8_WAIT_L(n) asm volatile("s_waitcnt lgkmcnt(" #n ")" ::: "memory")
#define PG8_BAR __builtin_amdgcn_s_barrier()
#define PG8_SCHED __builtin_amdgcn_sched_barrier(0)
    Unit cur, nxt; int ui = 0;
    if (!S.next(0, cur)) return;
    f32x4 acc[2][2][4][2];
#pragma unroll
    for (int a = 0; a < 2; ++a)
#pragma unroll
        for (int b = 0; b < 2; ++b)
#pragma unroll
            for (int m = 0; m < 4; ++m)
#pragma unroll
                for (int n = 0; n < 2; ++n) acc[a][b][m][n] = (f32x4){0.f, 0.f, 0.f, 0.f};
    bf16x8 At[4][2], B0[2][2], B1[2][2];
    const char* cA = (const char*)g.A + (size_t)cur.pm * tstep; const char* cB = (const char*)g.Bt + (size_t)cur.pn * tstep;
    S.a_ready(cur);
    if constexpr (SP2) {
        PG8_STAGE(PG8_SB(0, 0), cB, voffB); PG8_STAGE(PG8_SB(0, 1), cB + hstep, voffB); PG8_STAGE(PG8_SA(0, 0), cA, voffA); PG8_STAGE(PG8_SA(0, 1), cA + hstep, voffA);
        if (wr == 1) PG8_BAR;
        PG8_WAIT_V(2); PG8_BAR;
        PG8_STAGE(PG8_SB(1, 0), cB + kstep, voffB); PG8_STAGE(PG8_SA(1, 0), cA + kstep, voffA); PG8_STAGE(PG8_SB(1, 1), cB + hstep + kstep, voffB);
        PG8_WAIT_V(6); PG8_BAR;
    } else {
        PG8_STAGE(PG8_SB(0, 0), cB, voffB); PG8_STAGE(PG8_SA(0, 0), cA, voffA); PG8_STAGE(PG8_SB(0, 1), cB + hstep, voffB); PG8_STAGE(PG8_SA(0, 1), cA + hstep, voffA);
        if (wr == 1) PG8_BAR;
        PG8_WAIT_V(4); PG8_BAR;
        PG8_STAGE(PG8_SB(1, 0), cB + kstep, voffB); PG8_STAGE(PG8_SA(1, 0), cA + kstep, voffA); PG8_STAGE(PG8_SB(1, 1), cB + hstep + kstep, voffB);
        PG8_WAIT_V(6); PG8_BAR;
    }
    for (;;) {
        const bool has_next = S.next(ui + 1, nxt);
        const char* nA = has_next ? (const char*)g.A + (size_t)nxt.pm * tstep : cA; const char* nB = has_next ? (const char*)g.Bt + (size_t)nxt.pn * tstep : cB;
        for (int t = 0; t < nt; t += 2) {
            const bool last = (t == nt - 2);
            const char* a1 = cA + (size_t)(t + 1) * kstep;
            const char* a2 = last ? nA : cA + (size_t)(t + 2) * kstep; const char* b2 = last ? nB : cB + (size_t)(t + 2) * kstep;
            const char* a3 = a2 + kstep; const char* b3 = b2 + kstep;
            if (last && has_next) S.a_ready(nxt);
            if constexpr (SP2) {
            PG8_LDB(B0, 0, 0); PG8_LDB(B1, 0, 1); PG8_SCHED; PG8_LDA(At, 0, 0); PG8_STAGE(PG8_SA(1, 1), a1 + hstep, voffA);
            PG8_WAIT_V(8); PG8_WAIT_L(0); PG8_BAR; PG8_MMA(0, 0, At, B0); PG8_MMA(0, 1, At, B1); PG8_BAR; PG8_SCHED;
            PG8_LDA(At, 0, 1); PG8_STAGE(PG8_SB(0, 0), b2, voffB); PG8_STAGE(PG8_SB(0, 1), b2 + hstep, voffB); PG8_STAGE(PG8_SA(0, 0), a2, voffA);
            PG8_WAIT_V(8); PG8_WAIT_L(0); PG8_BAR; PG8_MMA(1, 0, At, B0); PG8_MMA(1, 1, At, B1); PG8_BAR; PG8_SCHED;
            PG8_LDB(B0, 1, 0); PG8_LDB(B1, 1, 1); PG8_SCHED; PG8_LDA(At, 1, 0); PG8_STAGE(PG8_SA(0, 1), a2 + hstep, voffA);
            PG8_WAIT_V(8); PG8_WAIT_L(0); PG8_BAR; PG8_MMA(0, 0, At, B0); PG8_MMA(0, 1, At, B1); PG8_BAR; PG8_SCHED;
            PG8_LDA(At, 1, 1); PG8_STAGE(PG8_SB(1, 0), b3, voffB); PG8_STAGE(PG8_SB(1, 1), b3 + hstep, voffB); PG8_STAGE(PG8_SA(1, 0), a3, voffA);
            PG8_WAIT_V(8); PG8_WAIT_L(0); PG8_BAR; PG8_MMA(1, 0, At, B0); PG8_MMA(1, 1, At, B1); PG8_BAR; PG8_SCHED;
            } else {
            PG8_LDB(B0, 0, 0); PG8_SCHED; PG8_LDA(At, 0, 0); PG8_STAGE(PG8_SA(1, 1), a1 + hstep, voffA);
            PG8_WAIT_L(8); PG8_BAR; PG8_WAIT_L(0); PG8_MMA(0, 0, At, B0); PG8_BAR; PG8_SCHED;
            PG8_LDB(B1, 0, 1); PG8_STAGE(PG8_SB(0, 0), b2, voffB);
            PG8_BAR; PG8_WAIT_L(0); PG8_MMA(0, 1, At, B1); PG8_BAR;
            PG8_LDA(At, 0, 1); PG8_STAGE(PG8_SA(0, 0), a2, voffA);
            PG8_BAR; PG8_WAIT_L(0); PG8_MMA(1, 0, At, B0); PG8_BAR; PG8_SCHED;
            PG8_STAGE(PG8_SB(0, 1), b2 + hstep, voffB);
            PG8_WAIT_V(6); PG8_BAR; PG8_MMA(1, 1, At, B1); PG8_BAR;
            PG8_LDB(B0, 1, 0); PG8_SCHED; PG8_LDA(At, 1, 0); PG8_STAGE(PG8_SA(0, 1), a2 + hstep, voffA);
            PG8_WAIT_L(8); PG8_BAR; PG8_WAIT_L(0); PG8_MMA(0, 0, At, B0); PG8_BAR; PG8_SCHED;
            PG8_LDB(B1, 1, 1); PG8_STAGE(PG8_SB(1, 0), b3, voffB);
            PG8_BAR; PG8_WAIT_L(0); PG8_MMA(0, 1, At, B1); PG8_BAR;
            PG8_LDA(At, 1, 1); PG8_STAGE(PG8_SA(1, 0), a3, voffA);
            PG8_BAR; PG8_WAIT_L(0); PG8_MMA(1, 0, At, B0); PG8_BAR; PG8_SCHED;
            PG8_STAGE(PG8_SB(1, 1), b3 + hstep, voffB);
            PG8_WAIT_V(6); PG8_BAR; PG8_MMA(1, 1, At, B1); PG8_BAR;
            }
        }
        if constexpr (ALIGN_EPI) { if (wr == 0) PG8_BAR; }
        if constexpr (!Epi::AFTER_DRAIN) { E(acc, cur, wr, wc, fr, fq); S.done(cur); }
        if (!has_next) break;
#pragma unroll
        for (int a = 0; a < 2; ++a)
#pragma unroll
            for (int b = 0; b < 2; ++b)
#pragma unroll
                for (int m = 0; m < 4; ++m)
#pragma unroll
                    for (int n = 0; n < 2; ++n) acc[a][b][m][n] = (f32x4){0.f, 0.f, 0.f, 0.f};
        cur = nxt; cA = nA; cB = nB; ++ui;
        if constexpr (ALIGN_EPI) { if (wr == 1) PG8_BAR; }
    }
    PG8_WAIT_V(0);
    if constexpr (!ALIGN_EPI) { if (wr == 0) PG8_BAR; }
    PG8_BAR;
    if constexpr (Epi::AFTER_DRAIN) { E.fused(acc, cur, wr, wc, fr, fq, lds, wid, lane); S.done(cur); }
#undef PG8_SA
#undef PG8_SB
#undef PG8_STAGE
#undef PG8_LDA
#undef PG8_LDB
#undef PG8_MMA
#undef PG8_WAIT_V
#undef PG8_WAIT_L
#undef PG8_BAR
#undef PG8_SCHED
}
}

constexpr int NB = 4, SEQ = 4096, D = 1024, M = NB * SEQ, BW = 512, FF = 2816, NIN = 6144, NINF = 6152, DEPTH = 4, NWAVES = 8;
constexpr int NCH = SEQ / 64;
constexpr float ALPHA = 1.6817928305074292f, LN_EPS = 1e-5f, LOG2E = 1.4426950408889634f;
constexpr float QSCALE = 0.125f * LOG2E;
constexpr size_t MiB = 1u << 20;
constexpr size_t WS_WIN = 1 * MiB, WS_WBR = 13 * MiB, WS_WOUT = 16 * MiB, WS_WGU = 18 * MiB, WS_WD = 29 * MiB, WS_WGLU = 35 * MiB, WS_WFG = 35 * MiB + 512 * 1024;
constexpr size_t WS_KERN = 36 * MiB, WS_WB = 37 * MiB, WS_WDD = 45 * MiB, WS_LAMC = 53 * MiB, WS_WAX = 53 * MiB + 256 * 1024;
constexpr size_t WS_XN = 54 * MiB;
constexpr size_t WS_Z = 86 * MiB;
constexpr size_t WS_G = 182 * MiB;
constexpr size_t WS_Y = 278 * MiB;
constexpr size_t WS_YS = 326 * MiB;
constexpr size_t WS_YI = 342 * MiB;
constexpr size_t WS_S = 374 * MiB;
constexpr size_t WS_LOGF = 378 * MiB;
constexpr size_t WS_AE = 379 * MiB, WS_HE = 379 * MiB + 512 * 1024;
constexpr size_t WS_END = 380 * MiB;
constexpr int LDS_BYTES = 147456;

#define LAS __attribute__((address_space(3)))
typedef unsigned short bf16;
typedef unsigned v4u __attribute__((ext_vector_type(4)));
typedef unsigned v2u __attribute__((ext_vector_type(2)));
typedef float f32x4 __attribute__((ext_vector_type(4)));
typedef float f32x16 __attribute__((ext_vector_type(16)));
typedef short bf16x8 __attribute__((ext_vector_type(8)));
typedef short s16x4 __attribute__((ext_vector_type(4)));
#define LDS_WAIT() asm volatile("s_waitcnt lgkmcnt(0)" ::: "memory")

__device__ __forceinline__ unsigned f2bf(float f) { unsigned u = __builtin_bit_cast(unsigned, f); return (u + 0x7fffu + ((u >> 16) & 1u)) >> 16; }
__device__ __forceinline__ unsigned pk2(float lo, float hi) { return f2bf(lo) | (f2bf(hi) << 16); }
__device__ __forceinline__ float bf2f(unsigned short b) { return __builtin_bit_cast(float, (unsigned)b << 16); }
__device__ __forceinline__ float bflo(unsigned w) { return __builtin_bit_cast(float, w << 16); }
__device__ __forceinline__ float bfhi(unsigned w) { return __builtin_bit_cast(float, w & 0xffff0000u); }
__device__ __forceinline__ float sigmoidf_(float x) { return __builtin_amdgcn_rcpf(1.f + __expf(-x)); }
__device__ __forceinline__ float gelu_tanh(float x) { const float u = 0.7978845608028654f * (x + 0.044715f * x * x * x); const float t = 1.f - 2.f * __builtin_amdgcn_rcpf(__expf(2.f * u) + 1.f); return 0.5f * x * (1.f + t); }
__device__ __forceinline__ float wave_sum(float v) {
#pragma unroll
    for (int o = 1; o < 64; o <<= 1) v += __shfl_xor(v, o);
    return v;
}
__device__ __forceinline__ int crow(int r, int hi) { return (r & 3) + 8 * (r >> 2) + 4 * hi; }

struct EpiG1 {
    static constexpr bool PERM = true, AFTER_DRAIN = false;
    bf16* Z; bf16* Gt; const float* bgate;
    __device__ __forceinline__ void operator()(const f32x4 (&acc)[2][2][4][2], const pg8::Unit& u, int wr, int wc, int fr, int fq) const {
        const int row0 = u.pm * 256 + wr * 64 + fr, pn = u.pn;
#pragma unroll
        for (int ai = 0; ai < 2; ++ai)
#pragma unroll
            for (int m = 0; m < 4; ++m) {
                const int row = row0 + ai * 128 + m * 16;
#pragma unroll
                for (int bj = 0; bj < 2; ++bj) {
                    f32x4 v0 = acc[ai][bj][m][0], v1 = acc[ai][bj][m][1];
                    const int ct = bj * 128 + wc * 32 + 8 * fq;
                    bf16* dst;
                    if (pn < 2) { const int col = pn * 256 + ct; dst = Z + ((size_t)(col >> 4) * M + row) * 16 + (col & 15); }
                    else if (pn < 12) { const int t = (pn - 2) >> 1; const int col = (pn & 1) * 256 + ct; dst = Z + (size_t)(1 + t) * M * 512 + (size_t)row * 512 + col; if (t == 2) { v0 = v0 * QSCALE; v1 = v1 * QSCALE; } }
                    else { const int col = (pn - 12) * 256 + ct; dst = Gt + (size_t)row * 3072 + col; const f32x4 b0 = *(const f32x4*)(bgate + col), b1 = *(const f32x4*)(bgate + col + 4);
#pragma unroll
                        for (int j = 0; j < 4; ++j) { v0[j] = sigmoidf_(v0[j] + b0[j]); v1[j] = sigmoidf_(v1[j] + b1[j]); } }
                    v4u w; w.x = pk2(v0[0], v0[1]); w.y = pk2(v0[2], v0[3]); w.z = pk2(v1[0], v1[1]); w.w = pk2(v1[2], v1[3]);
                    *(v4u*)dst = w;
                }
                asm volatile("" ::: "memory");
            }
    }
};
struct OrderG2 {
    pg8::StaticOrder base;
    __device__ __forceinline__ bool next(int i, pg8::Unit& u) const { const int r = i / 3, k = i - 3 * r; pg8::Unit t; if (!base.next(r, t)) return false; u.pm = k * 64 + t.pm; u.pn = k * 4 + t.pn; return true; }
    __device__ __forceinline__ void a_ready(const pg8::Unit&) const {}
    __device__ __forceinline__ void done(const pg8::Unit&) const {}
};
struct EpiG2 {
    static constexpr bool PERM = true, AFTER_DRAIN = false;
    const bf16* Gt; float* GSF; bf16* GS;
    __device__ __forceinline__ void operator()(const f32x4 (&acc)[2][2][4][2], const pg8::Unit& u, int wr, int wc, int fr, int fq) const {
        const int k = u.pm >> 6, pm = u.pm & 63, pn = u.pn & 3;
        const int row0 = pm * 256 + wr * 64 + fr;
#pragma unroll
        for (int ai = 0; ai < 2; ++ai)
#pragma unroll
            for (int m = 0; m < 4; ++m) {
                const int row = row0 + ai * 128 + m * 16;
#pragma unroll
                for (int bj = 0; bj < 2; ++bj) {
                    const int col = pn * 256 + bj * 128 + wc * 32 + 8 * fq;
                    const v4u gw = *(const v4u*)(Gt + (size_t)row * 3072 + k * 1024 + col);
                    f32x4 v0 = acc[ai][bj][m][0], v1 = acc[ai][bj][m][1];
                    v0[0] *= bflo(gw.x); v0[1] *= bfhi(gw.x); v0[2] *= bflo(gw.y); v0[3] *= bfhi(gw.y);
                    v1[0] *= bflo(gw.z); v1[1] *= bfhi(gw.z); v1[2] *= bflo(gw.w); v1[3] *= bfhi(gw.w);
                    float* sp = GSF + (size_t)row * 1024 + col;
                    if (k > 0) { v0 = v0 + *(const f32x4*)sp; v1 = v1 + *(const f32x4*)(sp + 4); }
                    if (k < 2) { *(f32x4*)sp = v0; *(f32x4*)(sp + 4) = v1; }
                    else { v4u w; w.x = pk2(v0[0], v0[1]); w.y = pk2(v0[2], v0[3]); w.z = pk2(v1[0], v1[1]); w.w = pk2(v1[2], v1[3]); *(v4u*)(GS + (size_t)row * 1024 + col) = w; }
                }
                asm volatile("" ::: "memory");
            }
    }
};
struct EpiRes {
    static constexpr bool PERM = false, AFTER_DRAIN = false;
    float* X;
    __device__ __forceinline__ void operator()(const f32x4 (&acc)[2][2][4][2], const pg8::Unit& u, int wr, int wc, int fr, int fq) const {
        const int row0 = u.pm * 256 + wr * 64 + fr, col0 = u.pn * 256 + wc * 32 + 4 * fq;
#pragma unroll
        for (int ai = 0; ai < 2; ++ai)
#pragma unroll
            for (int m = 0; m < 4; ++m) { float* rowp = X + (size_t)(row0 + ai * 128 + m * 16) * 1024 + col0;
#pragma unroll
                for (int bj = 0; bj < 2; ++bj)
#pragma unroll
                    for (int n = 0; n < 2; ++n) { f32x4* p = (f32x4*)(rowp + bj * 128 + n * 16); *p = (*p) * ALPHA + acc[ai][bj][m][n]; }
                asm volatile("" ::: "memory"); }
    }
};
struct EpiSwiGlu {
    static constexpr bool PERM = true, AFTER_DRAIN = false;
    bf16* H;
    __device__ __forceinline__ void operator()(const f32x4 (&acc)[2][2][4][2], const pg8::Unit& u, int wr, int wc, int fr, int fq) const {
        const int row0 = u.pm * 256 + wr * 64 + fr;
#pragma unroll
        for (int ai = 0; ai < 2; ++ai)
#pragma unroll
            for (int m = 0; m < 4; ++m) {
                const int row = row0 + ai * 128 + m * 16;
#pragma unroll
                for (int bj = 0; bj < 2; ++bj) {
                    const f32x4 g = acc[ai][bj][m][0], up = acc[ai][bj][m][1]; float h[4];
#pragma unroll
                    for (int j = 0; j < 4; ++j) h[j] = g[j] * sigmoidf_(g[j]) * up[j];
                    const int col = u.pn * 128 + bj * 64 + wc * 16 + 4 * fq;
                    v2u w; w.x = pk2(h[0], h[1]); w.y = pk2(h[2], h[3]);
                    *(v2u*)(H + (size_t)row * FF + col) = w;
                }
                asm volatile("" ::: "memory");
            }
    }
};
struct EpiGlu {
    static constexpr bool PERM = true, AFTER_DRAIN = false;
    const bf16* YS; bf16* Y0; const float* bglu;
    __device__ __forceinline__ void operator()(const f32x4 (&acc)[2][2][4][2], const pg8::Unit& u, int wr, int wc, int fr, int fq) const {
        const int row0 = u.pm * 256 + wr * 64 + fr;
#pragma unroll
        for (int ai = 0; ai < 2; ++ai)
#pragma unroll
            for (int m = 0; m < 4; ++m) {
                const int row = row0 + ai * 128 + m * 16;
#pragma unroll
                for (int bj = 0; bj < 2; ++bj) {
                    const int col = u.pn * 256 + bj * 128 + wc * 32 + 8 * fq;
                    const v4u yw = *(const v4u*)(YS + (size_t)row * 512 + col);
                    const f32x4 b0 = *(const f32x4*)(bglu + col), b1 = *(const f32x4*)(bglu + col + 4);
                    const f32x4 a0 = acc[ai][bj][m][0], a1 = acc[ai][bj][m][1];
                    float o[8];
                    o[0] = bflo(yw.x) * sigmoidf_(a0[0] + b0[0]); o[1] = bfhi(yw.x) * sigmoidf_(a0[1] + b0[1]); o[2] = bflo(yw.y) * sigmoidf_(a0[2] + b0[2]); o[3] = bfhi(yw.y) * sigmoidf_(a0[3] + b0[3]);
                    o[4] = bflo(yw.z) * sigmoidf_(a1[0] + b1[0]); o[5] = bfhi(yw.z) * sigmoidf_(a1[1] + b1[1]); o[6] = bflo(yw.w) * sigmoidf_(a1[2] + b1[2]); o[7] = bfhi(yw.w) * sigmoidf_(a1[3] + b1[3]);
                    v4u w; w.x = pk2(o[0], o[1]); w.y = pk2(o[2], o[3]); w.z = pk2(o[4], o[5]); w.w = pk2(o[6], o[7]);
                    *(v4u*)(Y0 + (size_t)row * 512 + col) = w;
                }
                asm volatile("" ::: "memory");
            }
    }
};

struct Args { const float* in[30]; float* out; unsigned char* ws; };
enum { I_X = 0, I_WIN, I_BF, I_BGATE, I_ARE, I_AIM, I_LOGDT, I_BRE, I_BIM, I_CRE, I_CIM, I_SD, I_WGLU, I_BGLU, I_CONVW, I_CONVB, I_WA, I_BA, I_WX, I_BX, I_LAM, I_WBR, I_WOUT, I_LN1G, I_LN1B, I_WFG, I_WFU, I_WFD, I_LN2G, I_LN2B };

__device__ __forceinline__ unsigned char* WSP(const Args& a) { unsigned char* p = a.ws; asm volatile("" : "+s"(p)); return p; }
__device__ __forceinline__ const float* INP(const Args& a, int i) { asm volatile("" : "+s"(i)); return a.in[i]; }
__device__ __forceinline__ void tr_item(const float* W, int ldw, int K, int col_off, int nblk, bf16* WT, int mode, int row_off, LAS float* scr, int item, int lane) {
    const int kb = item / nblk, nb = item - kb * nblk, k0 = 64 * kb, n0 = 32 * nb;
#pragma unroll 8
    for (int i = 0; i < 32; ++i) { const int kk = 2 * i + (lane >> 5); scr[kk * 33 + (lane & 31)] = W[(size_t)(k0 + kk) * ldw + col_off + n0 + (lane & 31)]; }
    LDS_WAIT();
    const int c = lane & 7;
#pragma unroll
    for (int j = 0; j < 4; ++j) { const int n = (lane >> 3) + 8 * j; const LAS float* s = scr + (8 * c) * 33 + n;
        v4u o; o.x = pk2(s[0 * 33], s[1 * 33]); o.y = pk2(s[2 * 33], s[3 * 33]); o.z = pk2(s[4 * 33], s[5 * 33]); o.w = pk2(s[6 * 33], s[7 * 33]);
        const int ns = n0 + n; const int orow = (mode == 0) ? (row_off + ns) : (8 * (ns >> 2) + (ns & 3) + (mode == 2 ? 4 : 0));
        *(v4u*)(WT + (size_t)orow * K + k0 + 8 * c) = o; }
    LDS_WAIT();
}
__device__ __forceinline__ void cexp_pow(float are, float aim, float dt, int j, float& re, float& im) {
    const float mag = expf(are * dt * (float)j);
    double ang = (double)aim * (double)dt * (double)j;
    ang -= rint(ang * 0.15915494309189535) * 6.283185307179586;
    const float a = (float)ang;
    re = mag * cosf(a); im = mag * sinf(a);
}
__device__ __forceinline__ void convert_phase(const Args& a, int l, LAS unsigned char* lds, int gw, int NGW, int wave, int lane) {
    asm volatile("" : "+v"(lane)); asm volatile("" : "+s"(wave), "+s"(gw));
    unsigned char* ws = WSP(a);
    LAS float* scr = (LAS float*)(lds + wave * 16384);
    constexpr int I0 = 16 * 96, I1 = I0 + 16 * 96, I2 = I1 + 3 * 8 * 32, I3 = I2 + 16 * 32, I4 = I3 + 16 * 88, I5 = I4 + 16 * 88, I6 = I5 + 44 * 32, I7 = I6 + 8 * 16;
    for (int it = gw; it < I7; it += NGW) {
        if (it < I0) tr_item(INP(a, I_WIN) + (size_t)l * D * NINF, NINF, D, 0, 96, (bf16*)(ws + WS_WIN), 0, 0, scr, it, lane);
        else if (it < I1) tr_item(INP(a, I_WIN) + (size_t)l * D * NINF, NINF, D, 3080, 96, (bf16*)(ws + WS_WIN), 0, 3072, scr, it - I0, lane);
        else if (it < I2) { const int r = it - I1, k = r / 256; tr_item(INP(a, I_WBR) + (size_t)(l * 3 + k) * BW * D, D, BW, 0, 32, (bf16*)(ws + WS_WBR), 0, k * 1024, scr, r - k * 256, lane); }
        else if (it < I3) tr_item(INP(a, I_WOUT) + (size_t)l * D * D, D, D, 0, 32, (bf16*)(ws + WS_WOUT), 0, 0, scr, it - I2, lane);
        else if (it < I4) tr_item(INP(a, I_WFG) + (size_t)l * D * FF, FF, D, 0, 88, (bf16*)(ws + WS_WGU), 1, 0, scr, it - I3, lane);
        else if (it < I5) tr_item(INP(a, I_WFU) + (size_t)l * D * FF, FF, D, 0, 88, (bf16*)(ws + WS_WGU), 2, 0, scr, it - I4, lane);
        else if (it < I6) tr_item(INP(a, I_WFD) + (size_t)l * FF * D, D, FF, 0, 32, (bf16*)(ws + WS_WD), 0, 0, scr, it - I5, lane);
        else tr_item(INP(a, I_WGLU) + (size_t)l * BW * BW, BW, BW, 0, 16, (bf16*)(ws + WS_WGLU), 0, 0, scr, it - I6, lane);
    }
    { float* wfg = (float*)(ws + WS_WFG); const float* win = INP(a, I_WIN) + (size_t)l * D * NINF;
      for (int e = gw * 64 + lane; e < 8 * D; e += NGW * 64) { const int h = e >> 10, k = e & 1023; wfg[e] = win[(size_t)k * NINF + 3072 + h]; } }
    { bf16* wax = (bf16*)(ws + WS_WAX);
      for (int e = gw * 64 + lane; e < 8 * 2 * 64 * 64; e += NGW * 64) { const int h = e >> 13, gt = (e >> 12) & 1, j = (e >> 6) & 63, i = e & 63;
          const float* src = (gt ? INP(a, I_WX) : INP(a, I_WA)) + ((size_t)(l * 8 + h) * 64 + i) * 64 + j; wax[e] = (bf16)f2bf(*src); } }
    {
        bf16* KERN = (bf16*)(ws + WS_KERN); bf16* WB = (bf16*)(ws + WS_WB); bf16* WDD = (bf16*)(ws + WS_WDD); float* LAMC = (float*)(ws + WS_LAMC);
        LAS float* Tre = scr; LAS float* Tim = scr + 1024;
        for (int it = gw; it < 32 * 65; it += NGW) {
            const int g = it / 65, j = it - g * 65, p = lane;
            const float are = INP(a, I_ARE)[(l * 32 + g) * 64 + p], aim = INP(a, I_AIM)[(l * 32 + g) * 64 + p], dt = expf(INP(a, I_LOGDT)[l * 32 + g]);
            float lbr, lbi, er, ei;
            cexp_pow(are, aim, dt, 1, lbr, lbi);
            cexp_pow(are, aim, dt, j, er, ei);
            const float nr = lbr - 1.f, ni = lbi, den = 1.f / (are * are + aim * aim);
            const float cfr = (nr * are + ni * aim) * den, cfi = (ni * are - nr * aim) * den;
            if (j == 64) { LAMC[(g * 64 + p) * 2] = er; LAMC[(g * 64 + p) * 2 + 1] = ei; }
            const float* cre = INP(a, I_CRE) + (size_t)(l * 32 + g) * 16 * 64; const float* cim = INP(a, I_CIM) + (size_t)(l * 32 + g) * 16 * 64;
            if (j >= 1) {
                const int t = j - 1;
#pragma unroll 4
                for (int c = 0; c < 16; ++c) { const float cr = cre[c * 64 + p], ci = cim[c * 64 + p];
                    bf16* d = WDD + ((size_t)g * 1024 + t * 16 + c) * 128 + p;
                    d[0] = (bf16)f2bf(cr * er - ci * ei); d[64] = (bf16)f2bf(-(cr * ei + ci * er)); }
            }
            if (j <= 63) {
                const f32x4* brp = (const f32x4*)(INP(a, I_BRE) + ((size_t)(l * 32 + g) * 64 + p) * 16); const f32x4* bip = (const f32x4*)(INP(a, I_BIM) + ((size_t)(l * 32 + g) * 64 + p) * 16);
                const int s = 63 - j;
                bf16* wbr = WB + ((size_t)g * 128 + p) * 1024 + s * 16; bf16* wbi = WB + ((size_t)g * 128 + 64 + p) * 1024 + s * 16;
#pragma unroll
                for (int q = 0; q < 4; ++q) { const f32x4 br = brp[q], bi = bip[q]; f32x4 tr, ti;
#pragma unroll
                    for (int e = 0; e < 4; ++e) { const float bbr = cfr * br[e] - cfi * bi[e], bbi = cfr * bi[e] + cfi * br[e]; tr[e] = er * bbr - ei * bbi; ti[e] = er * bbi + ei * bbr; }
                    *(LAS f32x4*)(Tre + p * 16 + 4 * q) = tr; *(LAS f32x4*)(Tim + p * 16 + 4 * q) = ti;
                    v2u w; w.x = pk2(tr[0], tr[1]); w.y = pk2(tr[2], tr[3]); *(v2u*)(wbr + 4 * q) = w;
                    w.x = pk2(ti[0], ti[1]); w.y = pk2(ti[2], ti[3]); *(v2u*)(wbi + 4 * q) = w; }
                LDS_WAIT();
                const int c = lane >> 2, cq = lane & 3; f32x4 acc = {0.f, 0.f, 0.f, 0.f};
#pragma unroll 4
                for (int p4 = 0; p4 < 16; ++p4) { const f32x4 cr = *(const f32x4*)(cre + c * 64 + 4 * p4), ci = *(const f32x4*)(cim + c * 64 + 4 * p4);
#pragma unroll
                    for (int e = 0; e < 4; ++e) { const f32x4 tr = *(const LAS f32x4*)(Tre + (4 * p4 + e) * 16 + 4 * cq), ti = *(const LAS f32x4*)(Tim + (4 * p4 + e) * 16 + 4 * cq); acc = acc + tr * cr[e] - ti * ci[e]; } }
                v2u w; w.x = pk2(acc[0], acc[1]); w.y = pk2(acc[2], acc[3]);
                *(v2u*)(KERN + (((size_t)g * 64 + j) * 16 + c) * 16 + 4 * cq) = w;
                LDS_WAIT();
            }
        }
    }
}

__device__ __forceinline__ void ln_phase(const float* src, float* X, bf16* XN, const float* gam, const float* bet, int gw, int NGW, int lane) {
    asm volatile("" : "+v"(lane)); asm volatile("" : "+s"(gw));
    for (int m = gw; m < M; m += NGW) {
        const f32x4* xr = (const f32x4*)(src + (size_t)m * D) + lane;
        f32x4 v[4];
#pragma unroll
        for (int j = 0; j < 4; ++j) v[j] = xr[64 * j];
        if (gam) {
            float s = 0.f;
#pragma unroll
            for (int j = 0; j < 4; ++j) s += (v[j].x + v[j].y) + (v[j].z + v[j].w);
            const float mean = wave_sum(s) * (1.f / D); float s2 = 0.f;
#pragma unroll
            for (int j = 0; j < 4; ++j) { v[j] = v[j] - mean; s2 += (v[j].x * v[j].x + v[j].y * v[j].y) + (v[j].z * v[j].z + v[j].w * v[j].w); }
            const float rstd = 1.f / sqrtf(wave_sum(s2) * (1.f / D) + LN_EPS);
#pragma unroll
            for (int j = 0; j < 4; ++j) { const f32x4 gg = *((const f32x4*)gam + lane + 64 * j), bb = *((const f32x4*)bet + lane + 64 * j); v[j] = v[j] * rstd * gg + bb; }
        }
        f32x4* xo = (f32x4*)(X + (size_t)m * D) + lane; v2u* o8 = (v2u*)(XN + (size_t)m * D) + lane;
#pragma unroll
        for (int j = 0; j < 4; ++j) { xo[64 * j] = v[j]; v2u w; w.x = pk2(v[j].x, v[j].y); w.y = pk2(v[j].z, v[j].w); o8[64 * j] = w; }
    }
}

__device__ __forceinline__ void lru_local_item(const Args& a, int l, int item, LAS unsigned char* wl, int lane) {
    unsigned char* ws = WSP(a);
    const int h = item & 7, n = (item >> 3) & 63, b = item >> 9;
    const int ch = h * 64 + lane, fr = lane & 15, fq = lane >> 4;
    const bf16* XL = (const bf16*)(ws + WS_Z) + (size_t)1 * M * 512;
    bf16* HL = (bf16*)(ws + WS_XN); bf16* PP = HL + (size_t)M * 512;
    const bf16* WAX = (const bf16*)(ws + WS_WAX);
    bf16x8 Bf[2][4][2];
#pragma unroll
    for (int gt = 0; gt < 2; ++gt)
#pragma unroll
        for (int nt = 0; nt < 4; ++nt)
#pragma unroll
            for (int ks = 0; ks < 2; ++ks) Bf[gt][nt][ks] = *(const bf16x8*)(WAX + ((size_t)((h * 2 + gt) * 64 + 16 * nt + fr)) * 64 + 32 * ks + 8 * fq);
    const float* cwp = INP(a, I_CONVW) + (size_t)l * 4 * BW;
    const float cw0 = cwp[ch], cw1 = cwp[BW + ch], cw2 = cwp[2 * BW + ch], cw3 = cwp[3 * BW + ch], cb = INP(a, I_CONVB)[l * BW + ch];
    const float lamv = INP(a, I_LAM)[l * BW + ch];
    const float c8 = -8.f * log1pf(expf(-lamv));
    const float ba = INP(a, I_BA)[l * BW + ch], bx = INP(a, I_BX)[l * BW + ch];
    const size_t tok0 = (size_t)b * SEQ + n * 64;
    float xm3 = 0.f, xm2 = 0.f, xm1 = 0.f;
    if (n > 0) { xm3 = bf2f(XL[(tok0 - 3) * 512 + ch]); xm2 = bf2f(XL[(tok0 - 2) * 512 + ch]); xm1 = bf2f(XL[(tok0 - 1) * 512 + ch]); }
    LAS bf16* XC = (LAS bf16*)(wl + 2048);
    LAS float* RG = (LAS float*)(wl + 4352);
    float hloc = 0.f, P = 1.f;
    for (int mt = 0; mt < 4; ++mt) {
        float xc[16];
#pragma unroll
        for (int i = 0; i < 16; ++i) { const float xv = bf2f(XL[(tok0 + mt * 16 + i) * 512 + ch]); xc[i] = cb + cw0 * xm3 + cw1 * xm2 + cw2 * xm1 + cw3 * xv; xm3 = xm2; xm2 = xm1; xm1 = xv; XC[i * 72 + lane] = (bf16)f2bf(xc[i]); }
        LDS_WAIT();
        const bf16x8 A0 = *(const LAS bf16x8*)(XC + fr * 72 + 8 * fq), A1 = *(const LAS bf16x8*)(XC + fr * 72 + 32 + 8 * fq);
#pragma unroll
        for (int gt = 0; gt < 2; ++gt)
#pragma unroll
            for (int nt = 0; nt < 4; ++nt) { f32x4 acc = {0.f, 0.f, 0.f, 0.f};
                acc = __builtin_amdgcn_mfma_f32_16x16x32_bf16(A0, Bf[gt][nt][0], acc, 0, 0, 0);
                acc = __builtin_amdgcn_mfma_f32_16x16x32_bf16(A1, Bf[gt][nt][1], acc, 0, 0, 0);
#pragma unroll
                for (int e = 0; e < 4; ++e) RG[(gt * 16 + 4 * fq + e) * 64 + 16 * nt + fr] = acc[e]; }
        LDS_WAIT();
#pragma unroll
        for (int i = 0; i < 16; ++i) {
            const float ra = RG[i * 64 + lane] + ba, rx = RG[(16 + i) * 64 + lane] + bx;
            const float r = 1.f / (1.f + expf(-ra)), ig = 1.f / (1.f + expf(-rx));
            const float la = c8 * r, av = expf(la), mult = sqrtf(-expm1f(2.f * la));
            hloc = av * hloc + mult * ig * xc[i]; P *= av;
            const size_t o = (tok0 + mt * 16 + i) * 512 + ch;
            HL[o] = (bf16)f2bf(hloc); PP[o] = (bf16)f2bf(P);
        }
        LDS_WAIT();
    }
    float* AE = (float*)(ws + WS_AE); float* HE = (float*)(ws + WS_HE);
    AE[(size_t)(b * NCH + n) * 512 + ch] = P; HE[(size_t)(b * NCH + n) * 512 + ch] = hloc;
}
__device__ __forceinline__ void s5_intra_item(const Args& a, int item, LAS unsigned char* wl, int lane) {
    unsigned char* ws = WSP(a);
    const int g = item & 31, n = (item >> 5) & 63, b = item >> 11;
    const bf16* U2 = (const bf16*)(ws + WS_Z); const bf16* KERN = (const bf16*)(ws + WS_KERN); float* YI = (float*)(ws + WS_YI);
    LAS bf16* ut = (LAS bf16*)wl;
    const size_t tok0 = (size_t)b * SEQ + n * 64;
    { const v4u* src = (const v4u*)(U2 + ((size_t)g * M + tok0 + lane) * 16); const v4u x0 = src[0], x1 = src[1];
      *(LAS v4u*)(ut + (64 + lane) * 16) = x0; *(LAS v4u*)(ut + (64 + lane) * 16 + 8) = x1; }
    LDS_WAIT();
    const int fr = lane & 15, fq = lane >> 4;
    f32x4 acc[4];
#pragma unroll
    for (int mt = 0; mt < 4; ++mt) acc[mt] = (f32x4){0.f, 0.f, 0.f, 0.f};
    const bf16* kb = KERN + (((size_t)g * 64 + (fq >> 1)) * 16 + fr) * 16 + 8 * (fq & 1);
    const LAS bf16* ab = ut + (64 + fr - (fq >> 1)) * 16 + 8 * (fq & 1);
#pragma unroll
    for (int sg = 0; sg < 4; ++sg) {
        bf16x8 Bq[8];
#pragma unroll
        for (int q = 0; q < 8; ++q) Bq[q] = *(const bf16x8*)(kb + (size_t)(8 * sg + q) * 512);
#pragma unroll
        for (int q = 0; q < 8; ++q)
#pragma unroll
            for (int mt = sg; mt < 4; ++mt) {
                const bf16x8 A = *(const LAS bf16x8*)(ab + (16 * mt - 2 * (8 * sg + q)) * 16);
                acc[mt] = __builtin_amdgcn_mfma_f32_16x16x32_bf16(A, Bq[q], acc[mt], 0, 0, 0);
            }
    }
#pragma unroll
    for (int mt = 0; mt < 4; ++mt)
#pragma unroll
        for (int i = 0; i < 4; ++i) YI[(tok0 + 16 * mt + 4 * fq + i) * 512 + g * 16 + fr] = acc[mt][i];
    LDS_WAIT();
}
__device__ __forceinline__ void s5_state_item(const Args& a, int item, int lane) {
    unsigned char* ws = WSP(a);
    const int q = item & 3, rt = (item >> 2) & 15, g = item >> 6, b = rt >> 2, n0 = 16 * (rt & 3);
    const bf16* U2 = (const bf16*)(ws + WS_Z); const bf16* WB = (const bf16*)(ws + WS_WB); float* S = (float*)(ws + WS_S);
    const int fr = lane & 15, fq = lane >> 4;
    f32x4 acc[2];
    acc[0] = (f32x4){0.f, 0.f, 0.f, 0.f}; acc[1] = (f32x4){0.f, 0.f, 0.f, 0.f};
    const bf16* ap = U2 + ((size_t)g * M + (size_t)b * SEQ + (n0 + fr) * 64 + (fq >> 1)) * 16 + 8 * (fq & 1);
    const bf16* bp = WB + ((size_t)g * 128 + 32 * q + fr) * 1024 + 8 * fq;
#pragma unroll 8
    for (int slab = 0; slab < 32; ++slab) {
        const bf16x8 A = *(const bf16x8*)(ap + slab * 32);
        const bf16x8 B0 = *(const bf16x8*)(bp + slab * 32), B1 = *(const bf16x8*)(bp + 16 * 1024 + slab * 32);
        acc[0] = __builtin_amdgcn_mfma_f32_16x16x32_bf16(A, B0, acc[0], 0, 0, 0);
        acc[1] = __builtin_amdgcn_mfma_f32_16x16x32_bf16(A, B1, acc[1], 0, 0, 0);
    }
#pragma unroll
    for (int nt = 0; nt < 2; ++nt)
#pragma unroll
        for (int i = 0; i < 4; ++i) S[((size_t)(b * NCH + n0 + 4 * fq + i) * 32 + g) * 128 + 32 * q + 16 * nt + fr] = acc[nt][i];
}
__device__ __forceinline__ void fg_row(const Args& a, int l, int m, LAS unsigned char* lds, int lane) {
    const f32x4* xr = (const f32x4*)(a.out + (size_t)m * D) + lane;
    f32x4 v[4];
#pragma unroll
    for (int j = 0; j < 4; ++j) v[j] = xr[64 * j];
    const LAS f32x4* wf = (const LAS f32x4*)lds + lane;
    float mine = 0.f;
#pragma unroll
    for (int h = 0; h < 8; ++h) { float s = 0.f;
#pragma unroll
        for (int j = 0; j < 4; ++j) { const f32x4 w = wf[h * 256 + 64 * j]; s += (v[j].x * w.x + v[j].y * w.y) + (v[j].z * w.z + v[j].w * w.w); }
        s = wave_sum(s); if (lane == h) mine = s; asm volatile("" ::: "memory"); }
    if (lane < 8) { const float z = mine + INP(a, I_BF)[l * 8 + lane]; const float lf = fminf(z, 0.f) - log1pf(expf(-fabsf(z)));
        const int b = m >> 12, t = m & 4095; ((float*)(WSP(a) + WS_LOGF))[(size_t)(b * 8 + lane) * SEQ + t] = lf * LOG2E; }
}
__device__ __forceinline__ void slot_a(const Args& a, int l, LAS unsigned char* lds, int gw, int NGW, int wave, int lane, int tid) {
    asm volatile("" : "+v"(lane), "+v"(tid)); asm volatile("" : "+s"(wave), "+s"(gw));
    LAS unsigned char* wl = lds + 32768 + wave * 12800;
    { const f32x4* src = (const f32x4*)(WSP(a) + WS_WFG); LAS f32x4* dst = (LAS f32x4*)lds; for (int i = tid; i < 2048; i += 512) dst[i] = src[i]; }
    { LAS bf16* ut = (LAS bf16*)wl; const v4u z = {0u, 0u, 0u, 0u}; *(LAS v4u*)(ut + lane * 16) = z; *(LAS v4u*)(ut + lane * 16 + 8) = z; }
    LDS_WAIT(); __syncthreads();
#ifndef NO_LRU
    for (int it = gw; it < NB * NCH * 8; it += NGW) lru_local_item(a, l, it, wl, lane);
#endif
#ifndef NO_S5
    for (int it = gw; it < NB * NCH * 32; it += NGW) s5_intra_item(a, it, wl, lane);
    for (int it = gw; it < 4 * 512; it += NGW) s5_state_item(a, it, lane);
#endif
#ifndef NO_FG
    for (int m = gw; m < M; m += NGW) fg_row(a, l, m, lds, lane);
#endif
}

__device__ __forceinline__ void s5_carry_item(const Args& a, int l, int item, LAS unsigned char* lds, int wave, int lane) {
    unsigned char* ws = WSP(a);
    const int q = item & 3, rt = (item >> 2) & 15, g = item >> 6, b = rt >> 2, n0 = 16 * (rt & 3);
    const bf16* U2 = (const bf16*)(ws + WS_Z); const bf16* WDD = (const bf16*)(ws + WS_WDD); const float* S = (const float*)(ws + WS_S);
    const float* YI = (const float*)(ws + WS_YI); bf16* YS = (bf16*)(ws + WS_YS);
    LAS bf16* Hs = (LAS bf16*)(lds + 65536 + wave * 4096);
    const float lcr = ((const float*)(ws + WS_LAMC))[(g * 64 + lane) * 2], lci = ((const float*)(ws + WS_LAMC))[(g * 64 + lane) * 2 + 1];
    float hr = 0.f, hi_ = 0.f;
#pragma unroll 8
    for (int m = 0; m < n0 + 16; ++m) {
        if (m >= n0) { Hs[(m - n0) * 128 + lane] = (bf16)f2bf(hr); Hs[(m - n0) * 128 + 64 + lane] = (bf16)f2bf(hi_); }
        const float* sp = S + ((size_t)(b * NCH + m) * 32 + g) * 128;
        const float sr = sp[lane], si = sp[64 + lane];
        const float nr = lcr * hr - lci * hi_ + sr, ni = lcr * hi_ + lci * hr + si; hr = nr; hi_ = ni;
    }
    LDS_WAIT();
    const int fr = lane & 15, fq = lane >> 4;
    bf16x8 Af[4];
#pragma unroll
    for (int s = 0; s < 4; ++s) Af[s] = *(const LAS bf16x8*)(Hs + fr * 128 + 32 * s + 8 * fq);
    const float dsk = INP(a, I_SD)[l * BW + g * 16 + fr];
#pragma unroll 4
    for (int nt = 16 * q; nt < 16 * q + 16; ++nt) {
        f32x4 acc = {0.f, 0.f, 0.f, 0.f};
#pragma unroll
        for (int s = 0; s < 4; ++s) { const bf16x8 B = *(const bf16x8*)(WDD + ((size_t)g * 1024 + 16 * nt + fr) * 128 + 32 * s + 8 * fq); acc = __builtin_amdgcn_mfma_f32_16x16x32_bf16(Af[s], B, acc, 0, 0, 0); }
#pragma unroll
        for (int i = 0; i < 4; ++i) { const size_t tok = (size_t)b * SEQ + (n0 + 4 * fq + i) * 64 + nt;
            const float uu = bf2f(U2[((size_t)g * M + tok) * 16 + fr]);
            const float y = YI[tok * 512 + g * 16 + fr] + acc[i] + dsk * uu;
            YS[tok * 512 + g * 16 + fr] = (bf16)f2bf(gelu_tanh(y)); }
    }
    LDS_WAIT();
}
__device__ __forceinline__ void lru_apply_item(const Args& a, int item, int lane) {
    unsigned char* ws = WSP(a);
    const int h = item & 7, n = (item >> 3) & 63, b = item >> 9;
    const int ch = h * 64 + lane;
    const bf16* HL = (const bf16*)(ws + WS_XN); const bf16* PP = HL + (size_t)M * 512;
    const bf16* GL = (const bf16*)(ws + WS_Z) + (size_t)2 * M * 512;
    bf16* Y1 = (bf16*)(ws + WS_Y) + (size_t)M * 512;
    const float* AE = (const float*)(ws + WS_AE); const float* HE = (const float*)(ws + WS_HE);
    float hin = 0.f;
#pragma unroll 8
    for (int m = 0; m < n; ++m) hin = AE[(size_t)(b * NCH + m) * 512 + ch] * hin + HE[(size_t)(b * NCH + m) * 512 + ch];
    const size_t tok0 = (size_t)b * SEQ + n * 64;
#pragma unroll 8
    for (int t = 0; t < 64; ++t) { const size_t o = (tok0 + t) * 512 + ch;
        const float hv = bf2f(HL[o]) + bf2f(PP[o]) * hin;
        Y1[o] = (bf16)f2bf(gelu_tanh(bf2f(GL[o])) * hv); }
}
__device__ __forceinline__ void attn_pair(const Args& a, int b, int h, int s, LAS unsigned char* lds, int wave, int lane, int tid) {
    unsigned char* ws = WSP(a);
    const bf16* Q = (const bf16*)(ws + WS_Z) + (size_t)3 * M * 512; const bf16* K = Q + (size_t)M * 512; const bf16* V = K + (size_t)M * 512;
    bf16* O = (bf16*)(ws + WS_Y) + (size_t)2 * M * 512;
    LAS float* cum = (LAS float*)lds; LAS bf16* Ks = (LAS bf16*)(lds + 16384); LAS bf16* Vt = (LAS bf16*)(lds + 16384 + 9216); LAS float* wsum = (LAS float*)(lds + 16384 + 18432);
    const int r32 = lane & 31, hi = lane >> 5;
    __syncthreads();
    {
        const float* src = (const float*)(ws + WS_LOGF) + (size_t)(b * 8 + h) * SEQ + tid * 8;
        const f32x4 a0 = *(const f32x4*)src, a1 = *(const f32x4*)(src + 4);
        float v[8] = {a0.x, a0.y, a0.z, a0.w, a1.x, a1.y, a1.z, a1.w};
#pragma unroll
        for (int i = 1; i < 8; ++i) v[i] += v[i - 1];
        float incl = v[7];
#pragma unroll
        for (int o = 1; o < 64; o <<= 1) { const float t = __shfl_up(incl, o); if (lane >= o) incl += t; }
        if (lane == 63) wsum[wave] = incl;
        LDS_WAIT(); __syncthreads();
        float off = incl - v[7];
        for (int w = 0; w < wave; ++w) off += wsum[w];
        f32x4 o0 = {v[0] + off, v[1] + off, v[2] + off, v[3] + off}, o1 = {v[4] + off, v[5] + off, v[6] + off, v[7] + off};
        *(LAS f32x4*)(cum + tid * 8) = o0; *(LAS f32x4*)(cum + tid * 8 + 4) = o1;
    }
    LDS_WAIT(); __syncthreads();
    for (int uu = 0; uu < 2; ++uu) {
        const int qb = uu == 0 ? s : 15 - s, q0 = qb * 256;
        const int qrow = q0 + wave * 32 + r32;
        const size_t qtok = (size_t)b * SEQ + qrow;
        bf16x8 qf[4];
#pragma unroll
        for (int ds = 0; ds < 4; ++ds) qf[ds] = *(const bf16x8*)(Q + qtok * 512 + h * 64 + ds * 16 + hi * 8);
        const float cq = cum[qrow];
        float mrun = -1e30f, lrun = 0.f;
        f32x16 o[2];
#pragma unroll
        for (int r = 0; r < 16; ++r) { o[0][r] = 0.f; o[1][r] = 0.f; }
        const int NT = 4 * (qb + 1);
        const int srow = tid >> 3, schk = tid & 7;
        const bf16* kvp = K + ((size_t)b * SEQ + srow) * 512 + h * 64 + schk * 8;
        v4u kk = *(const v4u*)kvp, vv = *(const v4u*)(kvp + (size_t)M * 512);
        for (int j = 0; j < NT; ++j) {
            __syncthreads();
            { *(LAS v4u*)(Ks + srow * 72 + schk * 8) = kk;
              LAS bf16* vd = Vt + (schk * 8) * 72 + srow;
              vd[0] = (bf16)(vv.x & 0xffffu); vd[72] = (bf16)(vv.x >> 16); vd[144] = (bf16)(vv.y & 0xffffu); vd[216] = (bf16)(vv.y >> 16);
              vd[288] = (bf16)(vv.z & 0xffffu); vd[360] = (bf16)(vv.z >> 16); vd[432] = (bf16)(vv.w & 0xffffu); vd[504] = (bf16)(vv.w >> 16); }
            LDS_WAIT(); __syncthreads();
            if (j + 1 < NT) { const bf16* np = kvp + (size_t)(j + 1) * 64 * 512; kk = *(const v4u*)np; vv = *(const v4u*)(np + (size_t)M * 512); }
            if (64 * j <= q0 + wave * 32 + 31) {
                f32x16 p0, p1;
#pragma unroll
                for (int r = 0; r < 16; ++r) { p0[r] = 0.f; p1[r] = 0.f; }
#pragma unroll
                for (int ds = 0; ds < 4; ++ds) {
                    const bf16x8 k0 = *(const LAS bf16x8*)(Ks + r32 * 72 + ds * 16 + hi * 8);
                    const bf16x8 k1 = *(const LAS bf16x8*)(Ks + (32 + r32) * 72 + ds * 16 + hi * 8);
                    p0 = __builtin_amdgcn_mfma_f32_32x32x16_bf16(k0, qf[ds], p0, 0, 0, 0);
                    p1 = __builtin_amdgcn_mfma_f32_32x32x16_bf16(k1, qf[ds], p1, 0, 0, 0);
                }
                const bool diag = (64 * j + 63 > q0 + wave * 32);
                float mx = -1e30f;
#pragma unroll
                for (int r4 = 0; r4 < 4; ++r4) {
                    const int kvb = 64 * j + 8 * r4 + 4 * hi;
                    const f32x4 c0 = *(const LAS f32x4*)(cum + kvb), c1 = *(const LAS f32x4*)(cum + kvb + 32);
#pragma unroll
                    for (int e = 0; e < 4; ++e) { const int r = 4 * r4 + e;
                        float s0 = p0[r] + (cq - c0[e]), s1 = p1[r] + (cq - c1[e]);
                        if (diag) { if (kvb + e > qrow) s0 = -1e30f; if (kvb + e + 32 > qrow) s1 = -1e30f; }
                        p0[r] = s0; p1[r] = s1; mx = fmaxf(mx, fmaxf(s0, s1)); }
                }
                mx = fmaxf(mx, __shfl_xor(mx, 32));
                const float mnew = fmaxf(mrun, mx), alpha = __builtin_amdgcn_exp2f(mrun - mnew);
                float psum = 0.f;
#pragma unroll
                for (int r = 0; r < 16; ++r) { p0[r] = __builtin_amdgcn_exp2f(p0[r] - mnew); p1[r] = __builtin_amdgcn_exp2f(p1[r] - mnew); psum += p0[r] + p1[r]; }
                lrun = lrun * alpha + psum; mrun = mnew;
#pragma unroll
                for (int r = 0; r < 16; ++r) { o[0][r] *= alpha; o[1][r] *= alpha; }
                bf16x8 pk[4];
#pragma unroll
                for (int sl = 0; sl < 4; ++sl) {
                    v4u w;
                    if (sl < 2) { const int r0 = 8 * (sl & 1); w.x = pk2(p0[r0], p0[r0 + 1]); w.y = pk2(p0[r0 + 2], p0[r0 + 3]); w.z = pk2(p0[r0 + 4], p0[r0 + 5]); w.w = pk2(p0[r0 + 6], p0[r0 + 7]); }
                    else { const int r0 = 8 * (sl & 1); w.x = pk2(p1[r0], p1[r0 + 1]); w.y = pk2(p1[r0 + 2], p1[r0 + 3]); w.z = pk2(p1[r0 + 4], p1[r0 + 5]); w.w = pk2(p1[r0 + 6], p1[r0 + 7]); }
                    pk[sl] = __builtin_bit_cast(bf16x8, w);
                }
#pragma unroll
                for (int db = 0; db < 2; ++db)
#pragma unroll
                    for (int sl = 0; sl < 4; ++sl) {
                        const LAS bf16* vp = Vt + (32 * db + r32) * 72 + 16 * sl + 4 * hi;
                        const v2u lo = *(const LAS v2u*)vp, hh = *(const LAS v2u*)(vp + 8);
                        v4u w; w.x = lo.x; w.y = lo.y; w.z = hh.x; w.w = hh.y;
                        o[db] = __builtin_amdgcn_mfma_f32_32x32x16_bf16(__builtin_bit_cast(bf16x8, w), pk[sl], o[db], 0, 0, 0);
                    }
            }
        }
        lrun += __shfl_xor(lrun, 32);
        const float inv = 1.f / lrun;
#pragma unroll
        for (int db = 0; db < 2; ++db)
#pragma unroll
            for (int r4 = 0; r4 < 4; ++r4) { const int d = 32 * db + 8 * r4 + 4 * hi;
                v2u w; w.x = pk2(o[db][4 * r4] * inv, o[db][4 * r4 + 1] * inv); w.y = pk2(o[db][4 * r4 + 2] * inv, o[db][4 * r4 + 3] * inv);
                *(v2u*)(O + qtok * 512 + h * 64 + d) = w; }
    }
}
__device__ __forceinline__ void slot_b(const Args& a, int l, LAS unsigned char* lds, int gw, int NGW, int vcu, int G, int wave, int lane, int tid) {
    asm volatile("" : "+v"(lane), "+v"(tid)); asm volatile("" : "+s"(wave), "+s"(gw), "+s"(vcu));
#ifndef NO_B12
    for (int it = gw; it < NB * NCH * 8; it += NGW) lru_apply_item(a, it, lane);
    for (int it = gw; it < 4 * 512; it += NGW) s5_carry_item(a, l, it, lds, wave, lane);
#endif
#ifndef NO_ATTN
    for (int p = vcu; p < 256; p += G) attn_pair(a, p >> 6, (p >> 3) & 7, p & 7, lds, wave, lane, tid);
#endif
}

template <class Epi, class Sched, bool A_, bool B_> __device__ __forceinline__ void gemm_stub(LAS unsigned char*, const pg8::Gemm, const Sched&, const Epi&) {}
#if defined(NO_GEMM) || defined(NO_G1)
#define GEMMCALL_G1 gemm_stub
#else
#define GEMMCALL_G1 pg8::gemm_phase
#endif
#if defined(NO_GEMM) || defined(NO_GLU)
#define GEMMCALL_GLU gemm_stub
#else
#define GEMMCALL_GLU pg8::gemm_phase
#endif
#if defined(NO_GEMM) || defined(NO_G2)
#define GEMMCALL_G2 gemm_stub
#else
#define GEMMCALL_G2 pg8::gemm_phase
#endif
#if defined(NO_GEMM) || defined(NO_G3)
#define GEMMCALL_G3 gemm_stub
#else
#define GEMMCALL_G3 pg8::gemm_phase
#endif
#if defined(NO_GEMM) || defined(NO_G4)
#define GEMMCALL_G4 gemm_stub
#else
#define GEMMCALL_G4 pg8::gemm_phase
#endif
#if defined(NO_GEMM) || defined(NO_G5)
#define GEMMCALL_G5 gemm_stub
#else
#define GEMMCALL_G5 pg8::gemm_phase
#endif
#define XB_TMO      128
#define XB_XCNT(j)  (256  + 64 * (j))
#define XB_XSUB(j)  (1280 + 64 * (j))
#define XB_XGEN(j)  (2304 + 64 * (j))
#define XB_TOP      3328
#define XB_TOPGEN   3392
#define XCD_BAR_WORDS 3456
#define XB_SPIN_CAP (1u << 18)

__device__ __forceinline__ unsigned xb_ld(unsigned* p)              { return __hip_atomic_load(p, __ATOMIC_RELAXED, __HIP_MEMORY_SCOPE_AGENT); }
__device__ __forceinline__ unsigned xb_add(unsigned* p, unsigned v) { return __hip_atomic_fetch_add(p, v, __ATOMIC_RELAXED, __HIP_MEMORY_SCOPE_AGENT); }
__device__ __forceinline__ unsigned xb_xcc_id() { return (unsigned)__builtin_amdgcn_s_getreg((3 << 11) | 20) & 0xFu; }
#define XB_SPIN(cond, bar) do { unsigned _sp = 0; while (cond) { __builtin_amdgcn_s_sleep(1); \
    if ((++_sp & 255u) == 0u) { if (xb_ld(&(bar)[XB_TMO])) break; if (_sp > XB_SPIN_CAP) { atomicAdd(&(bar)[XB_TMO], 1u); break; } } } } while (0)

struct XcdBarrier {
    unsigned* bar; unsigned x;
    volatile LAS unsigned* st;
};

__device__ __forceinline__ XcdBarrier xcd_barrier_post(unsigned* bar, volatile LAS unsigned* st) {
    XcdBarrier b; b.bar = bar; b.x = xb_xcc_id(); b.st = st;
    if (threadIdx.x == 0) (void)xb_add(&bar[XB_XCNT(b.x)], 1u);
    return b;
}
__device__ __forceinline__ void xcd_barrier_complete(unsigned* bar, unsigned x, unsigned& nloc, unsigned& nx) {
    const unsigned G = gridDim.x * gridDim.y * gridDim.z;
    unsigned sum, cnt, mine, sp = 0u;
    for (;;) {
        sum = 0u; cnt = 0u; mine = 0u;
#pragma unroll
        for (unsigned j = 0; j < 16; ++j) { const unsigned c = xb_ld(&bar[XB_XCNT(j)]); sum += c; cnt += (c > 0u) ? 1u : 0u; mine = (j == x) ? c : mine; }
        if (sum == G) break;
        __builtin_amdgcn_s_sleep(1);
        if ((++sp & 255u) == 0u) { if (xb_ld(&bar[XB_TMO])) break; if (sp > XB_SPIN_CAP) { atomicAdd(&bar[XB_TMO], 1u); break; } }
    }
    nloc = mine > 0u ? mine : 1u; nx = cnt > 0u ? cnt : 1u;
}

__device__ __forceinline__ void xcd_barrier(const XcdBarrier& b) {
    asm volatile("s_waitcnt vmcnt(0)" ::: "memory");
    __syncthreads();
    if (threadIdx.x == 0) {
        unsigned* bar = b.bar;
        __builtin_amdgcn_s_waitcnt(0);
        unsigned nloc = b.st[0], nx = b.st[1];
        if (nloc == 0u) { xcd_barrier_complete(bar, b.x, nloc, nx); b.st[0] = nloc; b.st[1] = nx; }
        const unsigned old = xb_add(&bar[XB_XSUB(b.x)], 1u);
        const unsigned gen = old / nloc;
        if (old + 1u == (gen + 1u) * nloc) {
            __builtin_amdgcn_fence(__ATOMIC_RELEASE, "agent");
            asm volatile("s_waitcnt vmcnt(0)" ::: "memory");
            const unsigned og = xb_add(&bar[XB_TOP], 1u);
            const unsigned tg = og / nx;
            if (og + 1u == (tg + 1u) * nx) xb_add(&bar[XB_TOPGEN], 1u);
            else XB_SPIN(xb_ld(&bar[XB_TOPGEN]) == tg, bar);
            __builtin_amdgcn_fence(__ATOMIC_ACQUIRE, "agent");
            xb_add(&bar[XB_XGEN(b.x)], 1u);
            asm volatile("s_waitcnt vmcnt(0)" ::: "memory");
        } else {
            XB_SPIN(xb_ld(&bar[XB_XGEN(b.x)]) == gen, bar);
            __builtin_amdgcn_fence(__ATOMIC_ACQUIRE, "agent");
            asm volatile("s_waitcnt vmcnt(0)" ::: "memory");
        }
    }
    __syncthreads();
}


#define GRIDSYNC() xcd_barrier(xbar)
__global__ void __launch_bounds__(NWAVES * 64, 2) fwd_kernel(Args a) {
    extern __shared__ __attribute__((aligned(16))) unsigned char lds_raw[];
    cg::grid_group grid = cg::this_grid();
    LAS unsigned char* lds = (LAS unsigned char*)lds_raw;
    const int tid = threadIdx.x, lane = tid & 63, wave = __builtin_amdgcn_readfirstlane(tid >> 6);
    const int G = gridDim.x, bx = blockIdx.x;
    const int vcu = (G % 8 == 0) ? (bx % 8) * (G / 8) + bx / 8 : bx;
    const int gw = bx * NWAVES + wave, NGW = G * NWAVES;
    unsigned char* ws0 = WSP(a);
    bf16* XN0 = (bf16*)(ws0 + WS_XN);

    volatile LAS unsigned* xst = (volatile LAS unsigned*)(lds + LDS_BYTES - 64);
    if (tid < 2) xst[tid] = 0u;
    __syncthreads();
    const XcdBarrier xbar = xcd_barrier_post((unsigned*)a.ws, xst);
    ln_phase(INP(a, I_X), a.out, XN0, nullptr, nullptr, gw, NGW, lane);
#ifndef NO_CONV
    convert_phase(a, 0, lds, gw, NGW, wave, lane);
#endif
    grid.sync();

    for (int l = 0; l < DEPTH; ++l) {
        {
            unsigned char* ws = WSP(a); bf16* XN = (bf16*)(ws + WS_XN); (void)XN;
            pg8::Gemm g{XN, (const bf16*)(ws + WS_WIN), M, NIN, D}; pg8::StaticOrder S; S.init(M, NIN, G, bx);
            EpiG1 E{(bf16*)(ws + WS_Z), (bf16*)(ws + WS_G), INP(a, I_BGATE) + (size_t)l * 3072};
            GEMMCALL_G1<EpiG1, pg8::StaticOrder, true, true>(lds, g, S, E);
        }
        GRIDSYNC();
        slot_a(a, l, lds, gw, NGW, wave, lane, tid);
        GRIDSYNC();
        slot_b(a, l, lds, gw, NGW, vcu, G, wave, lane, tid);
        GRIDSYNC();
        {
            unsigned char* ws = WSP(a); bf16* XN = (bf16*)(ws + WS_XN); (void)XN;
            pg8::Gemm g{(const bf16*)(ws + WS_YS), (const bf16*)(ws + WS_WGLU), M, BW, BW}; pg8::StaticOrder S; S.init(M, BW, G, bx);
            EpiGlu E{(const bf16*)(ws + WS_YS), (bf16*)(ws + WS_Y), INP(a, I_BGLU) + (size_t)l * BW};
            GEMMCALL_GLU<EpiGlu, pg8::StaticOrder, true, true>(lds, g, S, E);
        }
        GRIDSYNC();
        {
            unsigned char* ws = WSP(a); bf16* XN = (bf16*)(ws + WS_XN); (void)XN;
            pg8::Gemm g{(const bf16*)(ws + WS_Y), (const bf16*)(ws + WS_WBR), 3 * M, 3 * D, BW}; OrderG2 S; S.base.init(M, D, G, bx);
            EpiG2 E{(const bf16*)(ws + WS_G), (float*)(ws + WS_Z + 32 * MiB), (bf16*)(ws + WS_Z)};
            GEMMCALL_G2<EpiG2, OrderG2, true, true>(lds, g, S, E);
        }
        GRIDSYNC();
        {
            unsigned char* ws = WSP(a); bf16* XN = (bf16*)(ws + WS_XN); (void)XN;
            pg8::Gemm g{(const bf16*)(ws + WS_Z), (const bf16*)(ws + WS_WOUT), M, D, D}; pg8::StaticOrder S; S.init(M, D, G, bx);
            EpiRes E{a.out};
            GEMMCALL_G3<EpiRes, pg8::StaticOrder, true, true>(lds, g, S, E);
        }
        GRIDSYNC();
        ln_phase(a.out, a.out, (bf16*)(WSP(a) + WS_XN), INP(a, I_LN1G) + (size_t)l * D, INP(a, I_LN1B) + (size_t)l * D, gw, NGW, lane);
        GRIDSYNC();
        {
            unsigned char* ws = WSP(a); bf16* XN = (bf16*)(ws + WS_XN); (void)XN;
            pg8::Gemm g{XN, (const bf16*)(ws + WS_WGU), M, 2 * FF, D}; pg8::StaticOrder S; S.init(M, 2 * FF, G, bx);
            EpiSwiGlu E{(bf16*)(ws + WS_Z)};
            GEMMCALL_G4<EpiSwiGlu, pg8::StaticOrder, true, true>(lds, g, S, E);
        }
        GRIDSYNC();
        {
            unsigned char* ws = WSP(a); bf16* XN = (bf16*)(ws + WS_XN); (void)XN;
            pg8::Gemm g{(const bf16*)(ws + WS_Z), (const bf16*)(ws + WS_WD), M, D, FF}; pg8::StaticOrder S; S.init(M, D, G, bx);
            EpiRes E{a.out};
            GEMMCALL_G5<EpiRes, pg8::StaticOrder, true, true>(lds, g, S, E);
        }
        GRIDSYNC();
        ln_phase(a.out, a.out, (bf16*)(WSP(a) + WS_XN), INP(a, I_LN2G) + (size_t)l * D, INP(a, I_LN2B) + (size_t)l * D, gw, NGW, lane);
#ifndef NO_CONV
        if (l + 1 < DEPTH) convert_phase(a, l + 1, lds, gw, NGW, wave, lane);
#endif
        GRIDSYNC();
    }
}

extern "C" void kernel_launch(void* const* d_in, const int* in_sizes, int n_in, void* d_out, int out_size, void* d_ws, size_t ws_size, hipStream_t stream) {
    static int grid = 0;
    if (grid == 0) {
        if (n_in != 30 || out_size != M * D || ws_size < WS_END) { fprintf(stderr, "kernel_launch: unexpected shapes (n_in %d out %d ws %zu)\n", n_in, out_size, ws_size); grid = -1; return; }
        int dev = 0, cus = 0, per_cu = 0;
        (void)hipGetDevice(&dev); (void)hipDeviceGetAttribute(&cus, hipDeviceAttributeMultiprocessorCount, dev);
        (void)hipFuncSetAttribute((const void*)fwd_kernel, hipFuncAttributeMaxDynamicSharedMemorySize, LDS_BYTES);
        if (hipOccupancyMaxActiveBlocksPerMultiprocessor(&per_cu, (const void*)fwd_kernel, NWAVES * 64, LDS_BYTES) != hipSuccess || per_cu < 1) { fprintf(stderr, "kernel_launch: occupancy query says %d\n", per_cu); per_cu = 1; }
        (void)hipGetLastError();
        grid = cus;
    }
    if (grid < 0) return;
    if (hipMemsetAsync(d_ws, 0, 16384, stream) != hipSuccess) { fprintf(stderr, "kernel_launch: memset failed\n"); return; }
    Args a{};
    for (int i = 0; i < 30; ++i) a.in[i] = (const float*)d_in[i];
    a.out = (float*)d_out; a.ws = (unsigned char*)d_ws;
    void* args[] = {&a};
    hipError_t e = hipLaunchCooperativeKernel((const void*)fwd_kernel, dim3(grid), dim3(NWAVES * 64), args, LDS_BYTES, stream);
    if (e != hipSuccess) fprintf(stderr, "kernel_launch: cooperative launch failed: %s (grid %d)\n", hipGetErrorString(e), grid);
}
```
